# Optimizing an MI355X kernel written in HIP

```python
import math
import jax, jax.numpy as jnp
from jax import lax
import numpy as np

D_MODEL = 1024
BATCH = 32
SEQ = 2048
DEPTH = 1

SB_HEADS = 8
SB_HEAD_DIM = 64
SB_WIDTH = SB_HEADS * SB_HEAD_DIM
Q_BLOCK = 128
RW_HEADS = 8
RW_HEAD_DIM = 64
RW_WIDTH = RW_HEADS * RW_HEAD_DIM
DECAY_LORA = 64
ICLR_LORA = 64
GATE_LORA = 128
GN_EPS = 64e-5
D_FF = 4 * D_MODEL
PLE_DIM = 256
NORM_EPS = 1e-6

SB_COLS = 3 * SB_WIDTH
RW_COLS = 3 * RW_WIDTH + DECAY_LORA + ICLR_LORA + GATE_LORA
GATE_COLS = 2 * D_MODEL
IN_COLS = SB_COLS + RW_COLS + GATE_COLS

kernel_name = "hybrid_stickbreak_rwkv7_gated_block"


def rms_norm(x, g):
    xf = x.astype(jnp.float32)
    y = xf * lax.rsqrt(jnp.mean(xf * xf, axis=-1, keepdims=True) + NORM_EPS)
    return (y * g.astype(jnp.float32)).astype(x.dtype)


def stick_breaking_attention(q, k, v):
    q = jnp.transpose(q, (0, 2, 1, 3))
    k = jnp.transpose(k, (0, 2, 1, 3))
    v = jnp.transpose(v, (0, 2, 1, 3))
    seq = q.shape[2]
    scale = 1.0 / math.sqrt(q.shape[-1])
    outs = []
    for blk in range(seq // Q_BLOCK):
        q0 = blk * Q_BLOCK
        kend = q0 + Q_BLOCK
        z = jnp.einsum('bhqd,bhkd->bhqk', q[:, :, q0:kend], k[:, :, :kend]).astype(jnp.float32) * scale
        t_pos = q0 + jnp.arange(Q_BLOCK)[:, None]
        s_pos = jnp.arange(kend)[None, :]
        mask = s_pos < t_pos
        log_om = jnp.where(mask, jax.nn.log_sigmoid(-z), 0.0)
        rev = lax.cumsum(log_om, axis=log_om.ndim - 1, reverse=True)
        log_w = jax.nn.log_sigmoid(z) + rev - log_om
        w = jnp.where(mask, jnp.exp(log_w), 0.0)
        outs.append(jnp.einsum('bhqk,bhkd->bhqd', w.astype(v.dtype), v[:, :, :kend]))
    o = jnp.concatenate(outs, axis=2)
    return jnp.transpose(o, (0, 2, 1, 3))


def rwkv7_recurrence(r, w, k, v, a, b):
    bsz, _, heads, n = r.shape

    def step(state, inp):
        r_t, w_t, k_t, v_t, a_t, b_t = inp
        sa = jnp.einsum('bhvk,bhk->bhv', state, a_t)
        state = state * w_t[:, :, None, :] + sa[..., None] * b_t[:, :, None, :] + v_t[..., None] * k_t[:, :, None, :]
        y = jnp.einsum('bhvk,bhk->bhv', state, r_t)
        return state, y

    state0 = jnp.zeros((bsz, heads, n, n), jnp.float32)
    xs = tuple(jnp.moveaxis(t, 1, 0) for t in (r, w, k, v, a, b))
    _, ys = lax.scan(step, state0, xs)
    return jnp.moveaxis(ys, 0, 1)


def rwkv7_time_mix(u, shift_mu, w0, w2, a0, a2, g2, k_k, k_a, r_k, ln_w, ln_b):
    bsz, seq, _ = u.shape
    prev = jnp.pad(u, ((0, 0), (1, 0), (0, 0)))[:, :-1]
    u = u + (prev - u) * shift_mu
    r, k, v, xw, xa, xg = jnp.split(
        u, [RW_WIDTH, 2 * RW_WIDTH, 3 * RW_WIDTH, 3 * RW_WIDTH + DECAY_LORA,
            3 * RW_WIDTH + DECAY_LORA + ICLR_LORA], axis=-1)
    f32 = jnp.float32
    w_log = -jax.nn.softplus(-(w0 + jnp.tanh(xw) @ w2).astype(f32)) - 0.5
    decay = jnp.exp(-jnp.exp(w_log))
    a = jax.nn.sigmoid((a0 + xa @ a2).astype(f32))
    g = jax.nn.sigmoid(xg) @ g2
    hs = lambda t: t.astype(f32).reshape(bsz, seq, RW_HEADS, RW_HEAD_DIM)
    kk = hs(k * k_k)
    kk = kk / jnp.maximum(jnp.sqrt(jnp.sum(kk * kk, axis=-1, keepdims=True)), 1e-12)
    k_eff = hs(k.astype(f32) * (1.0 + (a - 1.0) * k_a.astype(f32)))
    a_h = a.reshape(bsz, seq, RW_HEADS, RW_HEAD_DIM)
    r_h, v_h = hs(r), hs(v)
    y = rwkv7_recurrence(r_h, decay.reshape(bsz, seq, RW_HEADS, RW_HEAD_DIM), k_eff, v_h, -kk, kk * a_h)
    mu = jnp.mean(y, axis=-1, keepdims=True)
    var = jnp.mean(jnp.square(y - mu), axis=-1, keepdims=True)
    y = ((y - mu) * lax.rsqrt(var + GN_EPS)).reshape(bsz, seq, RW_WIDTH)
    y = y * ln_w.astype(f32) + ln_b.astype(f32)
    bonus = jnp.sum(r_h * k_eff * r_k.astype(f32), axis=-1, keepdims=True) * v_h
    y = y + bonus.reshape(bsz, seq, RW_WIDTH)
    return (y * g.astype(f32)).astype(u.dtype)


def setup_inputs(seed: int = 0) -> dict:
    key = jax.random.key(seed)
    ks = jax.random.split(key, 26)
    nrm = lambda k, shape, fan_in: jax.random.normal(k, shape, jnp.float32) * (fan_in ** -0.5)
    gain = lambda k, shape: 1.0 + 0.02 * jax.random.normal(k, shape, jnp.float32)
    L = DEPTH
    return {
        "x": jax.random.normal(ks[0], (BATCH, SEQ, D_MODEL), jnp.float32),
        "p": jax.random.normal(ks[1], (DEPTH, BATCH, SEQ, PLE_DIM), jnp.float32),
        "attn_norm_g": gain(ks[2], (L, D_MODEL)),
        "w_in": nrm(ks[3], (L, D_MODEL, IN_COLS), D_MODEL),
        "shift_mu": jax.random.uniform(ks[4], (L, RW_COLS), jnp.float32, 0.0, 1.0),
        "decay_w0": jax.random.uniform(ks[5], (L, RW_WIDTH), jnp.float32, -3.0, 1.0),
        "decay_w2": 0.5 * nrm(ks[6], (L, DECAY_LORA, RW_WIDTH), DECAY_LORA),
        "iclr_a0": 0.1 * jax.random.normal(ks[7], (L, RW_WIDTH), jnp.float32),
        "iclr_a2": 0.5 * nrm(ks[8], (L, ICLR_LORA, RW_WIDTH), ICLR_LORA),
        "gate_g2": nrm(ks[9], (L, GATE_LORA, RW_WIDTH), GATE_LORA),
        "k_k": 0.85 + 0.02 * jax.random.normal(ks[10], (L, RW_WIDTH), jnp.float32),
        "k_a": gain(ks[11], (L, RW_WIDTH)),
        "r_k": 0.1 * jax.random.normal(ks[12], (L, RW_HEADS, RW_HEAD_DIM), jnp.float32),
        "ln_x_w": gain(ks[13], (L, RW_WIDTH)),
        "ln_x_b": 0.01 * jax.random.normal(ks[14], (L, RW_WIDTH), jnp.float32),
        "w_up_sb": nrm(ks[15], (L, SB_WIDTH, D_MODEL), SB_WIDTH),
        "w_up_rw": nrm(ks[16], (L, RW_WIDTH, D_MODEL), RW_WIDTH),
        "w_out": nrm(ks[17], (L, D_MODEL, D_MODEL), D_MODEL),
        "mlp_norm_g": gain(ks[18], (L, D_MODEL)),
        "w_ff1": nrm(ks[19], (L, D_MODEL, D_FF), D_MODEL),
        "w_ff2": nrm(ks[20], (L, D_FF, D_MODEL), D_FF),
        "ple_norm_g": gain(ks[21], (L, D_MODEL)),
        "w_ple_gate": nrm(ks[22], (L, D_MODEL, D_MODEL), D_MODEL),
        "w_ple_proj": nrm(ks[23], (L, PLE_DIM, D_MODEL), PLE_DIM),
        "final_norm_g": gain(ks[24], (D_MODEL,)),
    }


def reference(x, p, attn_norm_g, w_in, shift_mu, decay_w0, decay_w2, iclr_a0, iclr_a2, gate_g2,
              k_k, k_a, r_k, ln_x_w, ln_x_b, w_up_sb, w_up_rw, w_out, mlp_norm_g, w_ff1, w_ff2,
              ple_norm_g, w_ple_gate, w_ple_proj, final_norm_g):
    bsz, seq, _ = x.shape
    for i in range(DEPTH):
        h = rms_norm(x, attn_norm_g[i])
        u = h @ w_in[i]
        u_sb, u_rw, u_gate = jnp.split(u, [SB_COLS, SB_COLS + RW_COLS], axis=-1)
        q, k, v = jnp.split(u_sb.reshape(bsz, seq, 3 * SB_HEADS, SB_HEAD_DIM), 3, axis=2)
        o_sb = stick_breaking_attention(q, k, v).reshape(bsz, seq, SB_WIDTH)
        o_rw = rwkv7_time_mix(u_rw, shift_mu[i], decay_w0[i], decay_w2[i], iclr_a0[i], iclr_a2[i],
                              gate_g2[i], k_k[i], k_a[i], r_k[i], ln_x_w[i], ln_x_b[i])
        g_sb, g_rw = jnp.split(jax.nn.sigmoid(u_gate), 2, axis=-1)
        merged = g_sb * (o_sb @ w_up_sb[i]) + g_rw * (o_rw @ w_up_rw[i])
        x = x + merged @ w_out[i]
        h = rms_norm(x, mlp_norm_g[i])
        x = x + jnp.square(jax.nn.relu(h @ w_ff1[i])) @ w_ff2[i]
        gate = jax.nn.sigmoid(rms_norm(x, ple_norm_g[i]) @ w_ple_gate[i])
        x = x + gate * (p[i] @ w_ple_proj[i])
    return rms_norm(x, final_norm_g)
```

```cpp
#include <hip/hip_runtime.h>
#include <hip/hip_cooperative_groups.h>
#include <cstdio>
#include <cstdint>
namespace cg = cooperative_groups;
namespace pg8 {
#define PG8_LAS __attribute__((address_space(3)))
typedef unsigned short bf16_t;
typedef short bf16x8 __attribute__((ext_vector_type(8)));
typedef float f32x4 __attribute__((ext_vector_type(4)));
typedef unsigned u32x4 __attribute__((ext_vector_type(4)));
constexpr int BM = 256, BK = 64, HALF = 128, HTB = HALF * BK * 2  , STAGE_BYTES = 8 * HTB, NXCD = 8, WGM = 8;

__host__ __device__ __forceinline__ int lds_byte(int r, int c) { const int st = (r >> 4) * 2 + (c >> 5), rr = r & 15, cc = c & 31, ob = rr * 64 + cc * 2; return st * 1024 + (ob ^ (((ob >> 9) & 1) << 5)); }
__host__ __device__ __forceinline__ void stage_rc(int b, int& R, int& C) { const int st = b / 1024, sb = b % 1024, swz = sb ^ (((sb >> 9) & 1) << 5); R = (st >> 1) * 16 + swz / 64; C = (st & 1) * 32 + (swz % 64) / 2; }
__host__ __device__ __forceinline__ int perm32(int rho) { const int n = rho >> 4, i = rho & 15; return 8 * (i >> 2) + 4 * n + (i & 3); }

struct Unit { int pm, pn; };
struct Gemm { const bf16_t* A; const bf16_t* Bt; int M, N, K; };

struct StaticOrder {
    int nM, nN, nwg, G, c;
    __host__ __device__ void init(int M, int N, int G_, int c_) { nM = M / BM; nN = N / BM; nwg = nM * nN; G = G_; c = c_; }
    __host__ __device__ bool next(int i, Unit& u) const {
        const long L = (long)i * G + c; if (L >= nwg) return false;
        int wgid = (int)L; { const int q = nwg / NXCD, r = nwg % NXCD, xcd = wgid % NXCD, off = wgid / NXCD; wgid = (xcd < r ? xcd * (q + 1) : r * (q + 1) + (xcd - r) * q) + off; }
        const int nig = WGM * nN, gid = wgid / nig, fm = gid * WGM, gsz = (nM - fm) < WGM ? (nM - fm) : WGM;
        u.pm = fm + ((wgid % nig) % gsz); u.pn = (wgid % nig) / gsz; return true;
    }
    __device__ __forceinline__ void a_ready(const Unit&) const {}
    __device__ __forceinline__ void done(const Unit&) const {}
};

template <class Epi, class Sched, bool ALIGN_EPI = false, bool SP2 = false>
__device__ __forceinline__ void gemm_phase(PG8_LAS unsigned char* lds, const Gemm g, const Sched& S, const Epi& E) {
    const int tid = threadIdx.x, wid = __builtin_amdgcn_readfirstlane(tid >> 6), lane = tid & 63, wr = wid >> 2, wc = wid & 3, fr = lane & 15, fq = lane >> 4;
    const int K = g.K, nt = K / BK;
    unsigned voffA[2], voffB[2];
#pragma unroll
    for (int i = 0; i < 2; ++i) { int R, C; stage_rc(tid * 16 + i * 8192, R, C); const int Rb = Epi::PERM ? ((R & ~31) + perm32(R & 31)) : R;
        voffA[i] = (unsigned)(R * K + C) * 2u; voffB[i] = (unsigned)(Rb * K + C) * 2u; }
    const size_t kstep = (size_t)(BK * 2);
    const size_t hstep = (size_t)HALF * K * 2;
    const size_t tstep = 2 * hstep;
    const unsigned ldsw = (unsigned)wid * 1024u;
    const int aoff = lds_byte(wr * 64 + fr, fq * 8), boff = lds_byte(wc * 32 + fr, fq * 8);
#define PG8_SA(b, h) (((b) * 2 + (h)) * HTB)
#define PG8_SB(b, h) ((4 + (b) * 2 + (h)) * HTB)
#define PG8_STAGE(bufoff, gbase, voff) do { _Pragma("unroll") for (int _i = 0; _i < 2; ++_i) \
        __builtin_amdgcn_global_load_lds((const unsigned*)((const char*)(gbase) + (voff)[_i]), (PG8_LAS unsigned*)(lds + (bufoff) + ldsw + _i * 8192), 16, 0, 0); } while (0)
#define PG8_LDA(dst, b, h) do { _Pragma("unroll") for (int m = 0; m < 4; ++m) _Pragma("unroll") for (int k = 0; k < 2; ++k) dst[m][k] = *(const PG8_LAS bf16x8*)(lds + PG8_SA(b, h) + aoff + m * 2048 + k * 1024); } while (0)
#define PG8_LDB(dst, b, h) do { _Pragma("unroll") for (int n = 0; n < 2; ++n) _Pragma("unroll") for (int k = 0; k < 2; ++k) dst[n][k] = *(const PG8_LAS bf16x8*)(lds + PG8_SB(b, h) + boff + n * 2048 + k * 1024); } while (0)
#define PG8_MMA(ai, bj, At, Bt) do { __builtin_amdgcn_s_setprio(1); _Pragma("unroll") for (int m = 0; m < 4; ++m) _Pragma("unroll") for (int n = 0; n < 2; ++n) _Pragma("unroll") for (int k = 0; k < 2; ++k) \
        acc[ai][bj][m][n] = __builtin_amdgcn_mfma_f32_16x16x32_bf16(Bt[n][k], At[m][k], acc[ai][bj][m][n], 0, 0, 0); __builtin_amdgcn_s_setprio(0); } while (0)
#define PG8_WAIT_V(n) asm volatile("s_waitcnt vmcnt(" #n ")" ::: "memory")
#define PG8_WAIT_L(n) asm volatile("s_waitcnt lgkmcnt(" #n ")" ::: "memory")
#define PG8_BAR __builtin_amdgcn_s_barrier()
#define PG8_SCHED __builtin_amdgcn_sched_barrier(0)
    Unit cur, nxt; int ui = 0;
    if (!S.next(0, cur)) return;
    f32x4 acc[2][2][4][2];
#pragma unroll
    for (int a = 0; a < 2; ++a)
#pragma unroll
        for (int b = 0; b < 2; ++b)
#pragma unroll
            for (int m = 0; m < 4; ++m)
#pragma unroll
                for (int n = 0; n < 2; ++n) acc[a][b][m][n] = (f32x4){0.f, 0.f, 0.f, 0.f};
    bf16x8 At[4][2], B0[2][2], B1[2][2];
    const char* cA = (const char*)g.A + (size_t)cur.pm * tstep; const char* cB = (const char*)g.Bt + (size_t)cur.pn * tstep;
    S.a_ready(cur);
    if constexpr (SP2) {
        PG8_STAGE(PG8_SB(0, 0), cB, voffB); PG8_STAGE(PG8_SB(0, 1), cB + hstep, voffB); PG8_STAGE(PG8_SA(0, 0), cA, voffA); PG8_STAGE(PG8_SA(0, 1), cA + hstep, voffA);
        if (wr == 1) PG8_BAR;
        PG8_WAIT_V(2); PG8_BAR;
        PG8_STAGE(PG8_SB(1, 0), cB + kstep, voffB); PG8_STAGE(PG8_SA(1, 0), cA + kstep, voffA); PG8_STAGE(PG8_SB(1, 1), cB + hstep + kstep, voffB);
        PG8_WAIT_V(6); PG8_BAR;
    } else {
        PG8_STAGE(PG8_SB(0, 0), cB, voffB); PG8_STAGE(PG8_SA(0, 0), cA, voffA); PG8_STAGE(PG8_SB(0, 1), cB + hstep, voffB); PG8_STAGE(PG8_SA(0, 1), cA + hstep, voffA);
        if (wr == 1) PG8_BAR;
        PG8_WAIT_V(4); PG8_BAR;
        PG8_STAGE(PG8_SB(1, 0), cB + kstep, voffB); PG8_STAGE(PG8_SA(1, 0), cA + kstep, voffA); PG8_STAGE(PG8_SB(1, 1), cB + hstep + kstep, voffB);
        PG8_WAIT_V(6); PG8_BAR;
    }
    for (;;) {
        const bool has_next = S.next(ui + 1, nxt);
        const char* nA = has_next ? (const char*)g.A + (size_t)nxt.pm * tstep : cA; const char* nB = has_next ? (const char*)g.Bt + (size_t)nxt.pn * tstep : cB;
        for (int t = 0; t < nt; t += 2) {
            const bool last = (t == nt - 2);
            const char* a1 = cA + (size_t)(t + 1) * kstep;
            const char* a2 = last ? nA : cA + (size_t)(t + 2) * kstep; const char* b2 = last ? nB : cB + (size_t)(t + 2) * kstep;
            const char* a3 = a2 + kstep; const char* b3 = b2 + kstep;
            if (last && has_next) S.a_ready(nxt);
            if constexpr (SP2) {
            PG8_LDB(B0, 0, 0); PG8_LDB(B1, 0, 1); PG8_SCHED; PG8_LDA(At, 0, 0); PG8_STAGE(PG8_SA(1, 1), a1 + hstep, voffA);
            PG8_WAIT_V(8); PG8_WAIT_L(0); PG8_BAR; PG8_MMA(0, 0, At, B0); PG8_MMA(0, 1, At, B1); PG8_BAR; PG8_SCHED;
            PG8_LDA(At, 0, 1); PG8_STAGE(PG8_SB(0, 0), b2, voffB); PG8_STAGE(PG8_SB(0, 1), b2 + hstep, voffB); PG8_STAGE(PG8_SA(0, 0), a2, voffA);
            PG8_WAIT_V(8); PG8_WAIT_L(0); PG8_BAR; PG8_MMA(1, 0, At, B0); PG8_MMA(1, 1, At, B1); PG8_BAR; PG8_SCHED;
            PG8_LDB(B0, 1, 0); PG8_LDB(B1, 1, 1); PG8_SCHED; PG8_LDA(At, 1, 0); PG8_STAGE(PG8_SA(0, 1), a2 + hstep, voffA);
            PG8_WAIT_V(8); PG8_WAIT_L(0); PG8_BAR; PG8_MMA(0, 0, At, B0); PG8_MMA(0, 1, At, B1); PG8_BAR; PG8_SCHED;
            PG8_LDA(At, 1, 1); PG8_STAGE(PG8_SB(1, 0), b3, voffB); PG8_STAGE(PG8_SB(1, 1), b3 + hstep, voffB); PG8_STAGE(PG8_SA(1, 0), a3, voffA);
            PG8_WAIT_V(8); PG8_WAIT_L(0); PG8_BAR; PG8_MMA(1, 0, At, B0); PG8_MMA(1, 1, At, B1); PG8_BAR; PG8_SCHED;
            } else {
            PG8_LDB(B0, 0, 0); PG8_SCHED; PG8_LDA(At, 0, 0); PG8_STAGE(PG8_SA(1, 1), a1 + hstep, voffA);
            PG8_WAIT_L(8); PG8_BAR; PG8_WAIT_L(0); PG8_MMA(0, 0, At, B0); PG8_BAR; PG8_SCHED;
            PG8_LDB(B1, 0, 1); PG8_STAGE(PG8_SB(0, 0), b2, voffB);
            PG8_BAR; PG8_WAIT_L(0); PG8_MMA(0, 1, At, B1); PG8_BAR;
            PG8_LDA(At, 0, 1); PG8_STAGE(PG8_SA(0, 0), a2, voffA);
            PG8_BAR; PG8_WAIT_L(0); PG8_MMA(1, 0, At, B0); PG8_BAR; PG8_SCHED;
            PG8_STAGE(PG8_SB(0, 1), b2 + hstep, voffB);
            PG8_WAIT_V(6); PG8_BAR; PG8_MMA(1, 1, At, B1); PG8_BAR;
            PG8_LDB(B0, 1, 0); PG8_SCHED; PG8_LDA(At, 1, 0); PG8_STAGE(PG8_SA(0, 1), a2 + hstep, voffA);
            PG8_WAIT_L(8); PG8_BAR; PG8_WAIT_L(0); PG8_MMA(0, 0, At, B0); PG8_BAR; PG8_SCHED;
            PG8_LDB(B1, 1, 1); PG8_STAGE(PG8_SB(1, 0), b3, voffB);
            PG8_BAR; PG8_WAIT_L(0); PG8_MMA(0, 1, At, B1); PG8_BAR;
            PG8_LDA(At, 1, 1); PG8_STAGE(PG8_SA(1, 0), a3, voffA);
            PG8_BAR; PG8_WAIT_L(0); PG8_MMA(1, 0, At, B0); PG8_BAR; PG8_SCHED;
            PG8_STAGE(PG8_SB(1, 1), b3 + hstep, voffB);
            PG8_WAIT_V(6); PG8_BAR; PG8_MMA(1, 1, At, B1); PG8_BAR;
            }
        }
        if constexpr (ALIGN_EPI) { if (wr == 0) PG8_BAR; }
        if constexpr (!Epi::AFTER_DRAIN) { E(acc, cur, wr, wc, fr, fq); S.done(cur); }
        if (!has_next) break;
#pragma unroll
        for (int a = 0; a < 2; ++a)
#pragma unroll
            for (int b = 0; b < 2; ++b)
#pragma unroll
                for (int m = 0; m < 4; ++m)
#pragma unroll
                    for (int n = 0; n < 2; ++n) acc[a][b][m][n] = (f32x4){0.f, 0.f, 0.f, 0.f};
        cur = nxt; cA = nA; cB = nB; ++ui;
        if constexpr (ALIGN_EPI) { if (wr == 1) PG8_BAR; }
    }
    PG8_WAIT_V(0);
    if constexpr (!ALIGN_EPI) { if (wr == 0) PG8_BAR; }
    PG8_BAR;
    if constexpr (Epi::AFTER_DRAIN) { E.fused(acc, cur, wr, wc, fr, fq, lds, wid, lane); S.done(cur); }
#undef PG8_SA
#undef PG8_SB
#undef PG8_STAGE
#undef PG8_LDA
#undef PG8_LDB
#undef PG8_MMA
#undef PG8_WAIT_V
#undef PG8_WAIT_L
#undef PG8_BAR
#undef PG8_SCHED
}
}

#define LAS __attribute__((address_space(3)))
constexpr int NB = 32, SEQ = 2048, DM = 1024, MT = NB * SEQ;
constexpr int NH = 8, HD = 64, SBW = 512, RWW = 512, RWC = 1792, GC = 2048, INC = 5376, FF = 4096, PLE = 256;
constexpr int NMAIN = 4864;
constexpr int NPH = 11;
#ifndef PROBE_PHASE
#define PROBE_PHASE -1
#endif
#ifndef MK_ONE_LAUNCH
#define MK_ONE_LAUNCH 1
#endif
constexpr size_t MiB = 1u << 20;
constexpr size_t WS_WIN = 2 * MiB, WS_WSB = 13 * MiB, WS_WRW = 14 * MiB, WS_WOUT = 15 * MiB, WS_W1 = 17 * MiB, WS_W2 = 25 * MiB, WS_WG = 33 * MiB, WS_WP = 35 * MiB,
                 WS_LW2 = 36 * MiB, WS_LA2 = 36 * MiB + 65536, WS_LG2 = 36 * MiB + 131072;
constexpr size_t WS_PB = 40 * MiB, WS_H = 72 * MiB, WS_Q = 200 * MiB, WS_K = 264 * MiB, WS_VT = 328 * MiB, WS_U = 392 * MiB, WS_G = 616 * MiB, WS_OSB = 872 * MiB, WS_ORW = 936 * MiB, WS_END = 1000 * MiB;
constexpr size_t WS_F = 200 * MiB, WS_TMP = 712 * MiB;
constexpr int LDS_BYTES = 147456;
constexpr size_t WS_XBAR = 900 * 1024;

typedef unsigned short bf16_t;
typedef float f32x2 __attribute__((ext_vector_type(2)));
typedef float f32x4 __attribute__((ext_vector_type(4)));
typedef float f32x16 __attribute__((ext_vector_type(16)));
typedef unsigned u32x2 __attribute__((ext_vector_type(2)));
typedef unsigned u32x4 __attribute__((ext_vector_type(4)));
typedef short bf16x8 __attribute__((ext_vector_type(8)));
typedef __bf16 bf16x2_t __attribute__((ext_vector_type(2)));

__device__ __forceinline__ unsigned pkbf(float lo, float hi) { f32x2 v = {lo, hi}; bf16x2_t b = __builtin_convertvector(v, bf16x2_t); return __builtin_bit_cast(unsigned, b); }
__device__ __forceinline__ float bflo(unsigned w) { return __uint_as_float(w << 16); }
__device__ __forceinline__ float bfhi(unsigned w) { return __uint_as_float(w & 0xffff0000u); }
__device__ __forceinline__ float flog1p_(float e) { return __builtin_amdgcn_logf(1.f + e) * 0.69314718f; }
__device__ __forceinline__ float sigm(float x) { return __builtin_amdgcn_rcpf(1.f + __expf(-x)); }
__device__ __forceinline__ float wave_sum(float v) {
#pragma unroll
    for (int o = 1; o < 64; o <<= 1) v += __shfl_xor(v, o);
    return v;
}
template <int CTRL> __device__ __forceinline__ float dppf(float v) { return __int_as_float(__builtin_amdgcn_update_dpp(0, __float_as_int(v), CTRL, 0xF, 0xF, true)); }
__device__ __forceinline__ float red8(float v) { v += dppf<0xB1>(v); v += dppf<0x4E>(v); v += dppf<0x141>(v); return v; }
__device__ __forceinline__ float red16(float v) { v = red8(v); v += dppf<0x140>(v); return v; }

struct NoPre {};
template <class F> struct EpiGen {
    static constexpr bool PERM = true, AFTER_DRAIN = false; F f;
    __device__ __forceinline__ void operator()(const pg8::f32x4 (&acc)[2][2][4][2], const pg8::Unit& u, int wr, int wc, int fr, int fq) const {
        const int row0 = u.pm * 256 + wr * 64 + fr, col0 = u.pn * 256 + wc * 32 + 8 * fq;
        if constexpr (F::NB == 1) {
            typename F::Pre p[2][4][2];
#pragma unroll
            for (int ai = 0; ai < 2; ++ai)
#pragma unroll
                for (int m = 0; m < 4; ++m)
#pragma unroll
                    for (int bj = 0; bj < 2; ++bj) f.pre(row0 + ai * 128 + m * 16, col0 + bj * 128, p[ai][m][bj]);
#pragma unroll
            for (int ai = 0; ai < 2; ++ai)
#pragma unroll
                for (int m = 0; m < 4; ++m)
#pragma unroll
                    for (int bj = 0; bj < 2; ++bj) f(row0 + ai * 128 + m * 16, col0 + bj * 128, acc[ai][bj][m][0], acc[ai][bj][m][1], p[ai][m][bj]);
        } else if constexpr (F::NB == 2) {
#pragma unroll
            for (int ai = 0; ai < 2; ++ai) {
                typename F::Pre p[4][2];
#pragma unroll
                for (int m = 0; m < 4; ++m)
#pragma unroll
                    for (int bj = 0; bj < 2; ++bj) f.pre(row0 + ai * 128 + m * 16, col0 + bj * 128, p[m][bj]);
#pragma unroll
                for (int m = 0; m < 4; ++m)
#pragma unroll
                    for (int bj = 0; bj < 2; ++bj) f(row0 + ai * 128 + m * 16, col0 + bj * 128, acc[ai][bj][m][0], acc[ai][bj][m][1], p[m][bj]);
            }
        } else {
#pragma unroll
            for (int ai = 0; ai < 2; ++ai)
#pragma unroll
                for (int mp = 0; mp < 2; ++mp) {
                    typename F::Pre p[2][2];
#pragma unroll
                    for (int mm = 0; mm < 2; ++mm)
#pragma unroll
                        for (int bj = 0; bj < 2; ++bj) f.pre(row0 + ai * 128 + (2 * mp + mm) * 16, col0 + bj * 128, p[mm][bj]);
#pragma unroll
                    for (int mm = 0; mm < 2; ++mm)
#pragma unroll
                        for (int bj = 0; bj < 2; ++bj) f(row0 + ai * 128 + (2 * mp + mm) * 16, col0 + bj * 128, acc[ai][bj][2 * mp + mm][0], acc[ai][bj][2 * mp + mm][1], p[mm][bj]);
                }
        }
    }
};
__device__ __forceinline__ u32x4 pack8(f32x4 a, f32x4 b) { u32x4 w; w.x = pkbf(a[0], a[1]); w.y = pkbf(a[2], a[3]); w.z = pkbf(b[0], b[1]); w.w = pkbf(b[2], b[3]); return w; }
__device__ __forceinline__ void unpack8(u32x4 w, f32x4& a, f32x4& b) { a = (f32x4){bflo(w.x), bfhi(w.x), bflo(w.y), bfhi(w.y)}; b = (f32x4){bflo(w.z), bfhi(w.z), bflo(w.w), bfhi(w.w)}; }
__device__ __forceinline__ f32x4 sigm4(f32x4 v) { return (f32x4){sigm(v[0]), sigm(v[1]), sigm(v[2]), sigm(v[3])}; }

struct FInproj {
    bf16_t *Q, *K, *U, *G; typedef NoPre Pre; static constexpr int NB = 1;
    __device__ __forceinline__ void pre(int, int, Pre&) const {}
    __device__ __forceinline__ void operator()(int row, int col, f32x4 v0, f32x4 v1, const Pre&) const {
        const int pn = col >> 8; bf16_t* p;
        if (pn < 2) { p = Q + (size_t)row * 512 + col; v0 = v0 * 0.125f; v1 = v1 * 0.125f; }
        else if (pn < 4) { p = K + (size_t)row * 512 + (col - 512); }
        else if (pn < 11) { p = U + (size_t)row * RWC + (col - 1024); }
        else { p = G + (size_t)row * GC + (col - 2816); }
        __builtin_nontemporal_store(pack8(v0, v1), (u32x4*)p);
    }
};
struct FStore {
    bf16_t* O; int ld; typedef NoPre Pre; static constexpr int NB = 1;
    __device__ __forceinline__ void pre(int, int, Pre&) const {}
    __device__ __forceinline__ void operator()(int row, int col, f32x4 v0, f32x4 v1, const Pre&) const { *(u32x4*)(O + (size_t)row * ld + col) = pack8(v0, v1); }
};
struct FMergeA {
    const bf16_t* G; bf16_t* MG; struct Pre { u32x4 g; }; static constexpr int NB = 2;
    __device__ __forceinline__ void pre(int row, int col, Pre& p) const { p.g = *(const u32x4*)(G + (size_t)row * GC + col); }
    __device__ __forceinline__ void operator()(int row, int col, f32x4 v0, f32x4 v1, const Pre& p) const {
        f32x4 g0, g1; unpack8(p.g, g0, g1); g0 = sigm4(g0); g1 = sigm4(g1);
        *(u32x4*)(MG + (size_t)row * DM + col) = pack8(g0 * v0, g1 * v1);
    }
};
struct FMergeB {
    const bf16_t* G; bf16_t* MG; struct Pre { u32x4 g, m; }; static constexpr int NB = 2;
    __device__ __forceinline__ void pre(int row, int col, Pre& p) const { p.g = *(const u32x4*)(G + (size_t)row * GC + 1024 + col); p.m = *(const u32x4*)(MG + (size_t)row * DM + col); }
    __device__ __forceinline__ void operator()(int row, int col, f32x4 v0, f32x4 v1, const Pre& p) const {
        f32x4 g0, g1, m0, m1; unpack8(p.g, g0, g1); g0 = sigm4(g0); g1 = sigm4(g1);
        unpack8(p.m, m0, m1);
        *(u32x4*)(MG + (size_t)row * DM + col) = pack8(m0 + g0 * v0, m1 + g1 * v1);
    }
};
__device__ __forceinline__ void row_ss_add(float* SS, int row, f32x4 o0, f32x4 o1) {
    float s = ((o0[0] * o0[0] + o0[1] * o0[1]) + (o0[2] * o0[2] + o0[3] * o0[3])) + ((o1[0] * o1[0] + o1[1] * o1[1]) + (o1[2] * o1[2] + o1[3] * o1[3]));
    s += __shfl_xor(s, 16); s += __shfl_xor(s, 32);
    if ((threadIdx.x & 48) == 0) atomicAdd(SS + row, s);
}
struct FRes4 {
    const float* base; bf16_t* XB; float* SS; struct Pre { f32x4 b0, b1; }; static constexpr int NB = 2;
    __device__ __forceinline__ void pre(int row, int col, Pre& p) const { const size_t o = (size_t)row * DM + col; p.b0 = *(const f32x4*)(base + o); p.b1 = *(const f32x4*)(base + o + 4); }
    __device__ __forceinline__ void operator()(int row, int col, f32x4 v0, f32x4 v1, const Pre& p) const {
        const size_t o = (size_t)row * DM + col; const f32x4 o0 = p.b0 + v0, o1 = p.b1 + v1;
        *(u32x4*)(XB + o) = pack8(o0, o1);
        row_ss_add(SS, row, o0, o1);
    }
};
struct FRes7 {
    const bf16_t* base; bf16_t* XB; float* SS; struct Pre { u32x4 b; }; static constexpr int NB = 2;
    __device__ __forceinline__ void pre(int row, int col, Pre& p) const { p.b = *(const u32x4*)(base + (size_t)row * DM + col); }
    __device__ __forceinline__ void operator()(int row, int col, f32x4 v0, f32x4 v1, const Pre& p) const {
        const size_t o = (size_t)row * DM + col; f32x4 b0, b1; unpack8(p.b, b0, b1); const f32x4 o0 = b0 + v0, o1 = b1 + v1;
        *(u32x4*)(XB + o) = pack8(o0, o1);
        row_ss_add(SS, row, o0, o1);
    }
};
struct FRelu2 {
    bf16_t* F; const float* SS; struct Pre { float ss; }; static constexpr int NB = 1;
    __device__ __forceinline__ void pre(int row, int, Pre& p) const { p.ss = SS[row]; }
    __device__ __forceinline__ void operator()(int row, int col, f32x4 v0, f32x4 v1, const Pre& p) const {
        const float rs = rsqrtf(p.ss * (1.f / DM) + 1e-6f);
        f32x4 z = {0.f, 0.f, 0.f, 0.f}; v0 = __builtin_elementwise_max(v0 * rs, z); v1 = __builtin_elementwise_max(v1 * rs, z);
        __builtin_nontemporal_store(pack8(v0 * v0, v1 * v1), (u32x4*)(F + (size_t)row * FF + col));
    }
};
struct FPle {
    const bf16_t* T; float* X; const float* SS; float* SS3; typedef NoPre Pre; static constexpr int NB = 1;
    __device__ __forceinline__ void pre(int, int, Pre&) const {}
    __device__ __forceinline__ void operator()(int row, int col, f32x4 v0, f32x4 v1, const Pre&) const {
        const float rs = rsqrtf(SS[row] * (1.f / DM) + 1e-6f);
        const size_t o = (size_t)row * DM + col; f32x4 t0, t1; unpack8(*(const u32x4*)(T + o), t0, t1);
        const f32x4 b0 = *(const f32x4*)(X + o), b1 = *(const f32x4*)(X + o + 4);
        const f32x4 o0 = b0 + sigm4(v0 * rs) * t0, o1 = b1 + sigm4(v1 * rs) * t1;
        *(f32x4*)(X + o) = o0; *(f32x4*)(X + o + 4) = o1;
        row_ss_add(SS3, row, o0, o1);
    }
};

struct EpiPleFinal {
    static constexpr bool PERM = true, AFTER_DRAIN = false;
    const bf16_t* T; const bf16_t* XB; float* X; const float* SS2; float* SS3; unsigned* CNT; const float* gfin;
    __device__ __forceinline__ void operator()(pg8::f32x4 (&acc)[2][2][4][2], const pg8::Unit& u, int wr, int wc, int fr, int fq) const {
        const int row0 = u.pm * 256 + wr * 64 + fr, col0 = u.pn * 256 + wc * 32 + 8 * fq;
        float rsum[2][4];
#pragma unroll
        for (int ai = 0; ai < 2; ++ai)
#pragma unroll
            for (int mp = 0; mp < 2; ++mp) {
                u32x4 tq[2][2], xq[2][2]; float s2[2];
#pragma unroll
                for (int mm = 0; mm < 2; ++mm) { const int row = row0 + ai * 128 + (2 * mp + mm) * 16; s2[mm] = SS2[row];
#pragma unroll
                    for (int bj = 0; bj < 2; ++bj) { const size_t o = (size_t)row * DM + col0 + bj * 128; tq[mm][bj] = *(const u32x4*)(T + o); xq[mm][bj] = *(const u32x4*)(XB + o); } }
#pragma unroll
                for (int mm = 0; mm < 2; ++mm) { const int m = 2 * mp + mm, row = row0 + ai * 128 + m * 16; const float rs = rsqrtf(s2[mm] * (1.f / DM) + 1e-6f); float ssum = 0.f;
#pragma unroll
                    for (int bj = 0; bj < 2; ++bj) {
                        f32x4 t0, t1, x0, x1; unpack8(tq[mm][bj], t0, t1); unpack8(xq[mm][bj], x0, x1);
                        const f32x4 o0 = x0 + sigm4(acc[ai][bj][m][0] * rs) * t0, o1 = x1 + sigm4(acc[ai][bj][m][1] * rs) * t1;
                        acc[ai][bj][m][0] = o0; acc[ai][bj][m][1] = o1;
                        ssum += ((o0[0] * o0[0] + o0[1] * o0[1]) + (o0[2] * o0[2] + o0[3] * o0[3])) + ((o1[0] * o1[0] + o1[1] * o1[1]) + (o1[2] * o1[2] + o1[3] * o1[3]));
                    }
                    ssum += __shfl_xor(ssum, 16); ssum += __shfl_xor(ssum, 32);
                    rsum[ai][m] = ssum; }
            }
        if (fq == 0) {
#pragma unroll
            for (int ai = 0; ai < 2; ++ai)
#pragma unroll
                for (int m = 0; m < 4; ++m) atomicAdd(SS3 + row0 + ai * 128 + m * 16, rsum[ai][m]);
        }
        asm volatile("s_waitcnt vmcnt(0)" ::: "memory");
        unsigned* cw = CNT + 64 * u.pm;
        if ((threadIdx.x & 63) == 0) __hip_atomic_fetch_add(cw, 1u, __ATOMIC_RELAXED, __HIP_MEMORY_SCOPE_AGENT);
        for (int spin = 0; spin < (1 << 22); ++spin) {
            if (__hip_atomic_load(cw, __ATOMIC_RELAXED, __HIP_MEMORY_SCOPE_AGENT) >= 32u) break;
            __builtin_amdgcn_s_sleep(2);
        }
        f32x4 gv[2][2];
#pragma unroll
        for (int bj = 0; bj < 2; ++bj) { gv[bj][0] = *(const f32x4*)(gfin + col0 + bj * 128); gv[bj][1] = *(const f32x4*)(gfin + col0 + bj * 128 + 4); }
        float ss3[2][4];
#pragma unroll
        for (int ai = 0; ai < 2; ++ai)
#pragma unroll
            for (int m = 0; m < 4; ++m) ss3[ai][m] = __hip_atomic_load(SS3 + row0 + ai * 128 + m * 16, __ATOMIC_RELAXED, __HIP_MEMORY_SCOPE_AGENT);
#pragma unroll
        for (int ai = 0; ai < 2; ++ai)
#pragma unroll
            for (int m = 0; m < 4; ++m) {
                const int row = row0 + ai * 128 + m * 16;
                const float rs = rsqrtf(ss3[ai][m] * (1.f / DM) + 1e-6f);
#pragma unroll
                for (int bj = 0; bj < 2; ++bj) { const size_t o = (size_t)row * DM + col0 + bj * 128;
                    __builtin_nontemporal_store(acc[ai][bj][m][0] * rs * gv[bj][0], (f32x4*)(X + o)); __builtin_nontemporal_store(acc[ai][bj][m][1] * rs * gv[bj][1], (f32x4*)(X + o + 4)); }
            }
    }
};

template <bool ALIGN = true, class F> __device__ __forceinline__ void run_gemm(LAS unsigned char* lds, const bf16_t* A, const bf16_t* Bt, int M, int N, int K, const F& f) {
    pg8::Gemm g{A, Bt, M, N, K}; pg8::StaticOrder S; S.init(M, N, (int)gridDim.x, (int)blockIdx.x);
    EpiGen<F> E{f};
    pg8::gemm_phase<EpiGen<F>, pg8::StaticOrder, ALIGN, true>(lds, g, S, E);
}

__device__ __forceinline__ void transpose_item(const float* W, int K, int N, bf16_t* WT, int k0, int n0, int dst_row0, LAS float* scr, int lane, const float* gk = nullptr) {
#pragma unroll 8
    for (int i = 0; i < 32; ++i) { const int kk = 2 * i + (lane >> 5); float wv = W[(size_t)(k0 + kk) * N + n0 + (lane & 31)]; if (gk) wv *= gk[k0 + kk]; scr[kk * 33 + (lane & 31)] = wv; }
    asm volatile("s_waitcnt lgkmcnt(0)" ::: "memory");
    const int c = lane & 7;
#pragma unroll
    for (int j = 0; j < 4; ++j) { const int n = (lane >> 3) + 8 * j; const LAS float* s = scr + (8 * c) * 33 + n;
        u32x4 o; o.x = pkbf(s[0 * 33], s[1 * 33]); o.y = pkbf(s[2 * 33], s[3 * 33]); o.z = pkbf(s[4 * 33], s[5 * 33]); o.w = pkbf(s[6 * 33], s[7 * 33]);
        *(u32x4*)(WT + (size_t)(dst_row0 + n) * K + k0 + 8 * c) = o; }
    asm volatile("s_waitcnt lgkmcnt(0)" ::: "memory");
}
__device__ __forceinline__ int win_dst(int n0) { return n0 < 1024 ? n0 : (n0 < 1536 ? n0 - 1024 + NMAIN : (n0 < 3328 ? n0 - 1536 + 1024 : n0 - 3328 + 2816)); }

__device__ __forceinline__ void rms_row_bf16(const float* xrow, const float* g, bf16_t* orow, int lane) {
    const f32x4* xr = (const f32x4*)xrow + lane; const f32x4* gr = (const f32x4*)g + lane;
    f32x4 v[4]; float s = 0.f;
#pragma unroll
    for (int j = 0; j < 4; ++j) { v[j] = xr[64 * j]; s += (v[j].x * v[j].x + v[j].y * v[j].y) + (v[j].z * v[j].z + v[j].w * v[j].w); }
    const float rstd = rsqrtf(wave_sum(s) * (1.f / DM) + 1e-6f);
    u32x2* o8 = (u32x2*)orow + lane;
#pragma unroll
    for (int j = 0; j < 4; ++j) { const f32x4 gg = gr[64 * j]; const f32x4 y = v[j] * rstd * gg; u32x2 w; w.x = pkbf(y.x, y.y); w.y = pkbf(y.z, y.w); o8[64 * j] = w; }
}
__device__ __forceinline__ void rms_row_f32(float* xrow, const float* g, int lane, float ss) {
    f32x4* xr = (f32x4*)xrow + lane; const f32x4* gr = (const f32x4*)g + lane;
    f32x4 v[4];
#pragma unroll
    for (int j = 0; j < 4; ++j) v[j] = xr[64 * j];
    const float rstd = rsqrtf(ss * (1.f / DM) + 1e-6f);
#pragma unroll
    for (int j = 0; j < 4; ++j) xr[64 * j] = v[j] * rstd * gr[64 * j];
}

__device__ __forceinline__ void sb_attn_unit(const bf16_t* __restrict__ Q, const bf16_t* __restrict__ K, const bf16_t* __restrict__ Vt, bf16_t* __restrict__ O, int bh, int qt, int lane) {
    const int b = bh >> 3, h = bh & 7, n = lane & 31, hi = lane >> 5;
    const size_t tok0 = (size_t)b * SEQ; const int q0 = qt * 32;
    bf16x8 qf[4];
#pragma unroll
    for (int d0 = 0; d0 < 4; ++d0) qf[d0] = *(const bf16x8*)(Q + (tok0 + q0 + n) * SBW + h * HD + d0 * 16 + hi * 8);
    f32x16 o0, o1;
#pragma unroll
    for (int r = 0; r < 16; ++r) { o0[r] = 0.f; o1[r] = 0.f; }
    float C = 0.f;
    const int mk = (n & ~12) | ((n & 4) << 1) | ((n & 8) >> 1);
    const bf16_t* vbase = Vt + (size_t)(h * HD + n) * MT + tok0 + 8 * hi;
    bf16x8 kn[4], vn[2][2];
    {
        const bf16_t* kp = K + (tok0 + qt * 32 + mk) * SBW + h * HD + hi * 8;
#pragma unroll
        for (int d0 = 0; d0 < 4; ++d0) kn[d0] = *(const bf16x8*)(kp + d0 * 16);
#pragma unroll
        for (int dh = 0; dh < 2; ++dh)
#pragma unroll
            for (int kk = 0; kk < 2; ++kk) vn[dh][kk] = *(const bf16x8*)(vbase + (size_t)dh * 32 * MT + qt * 32 + 16 * kk);
    }
    for (int kt = qt; kt >= 0; --kt) {
        const int k0 = kt * 32;
        bf16x8 kf[4], vf[2][2];
#pragma unroll
        for (int d0 = 0; d0 < 4; ++d0) kf[d0] = kn[d0];
#pragma unroll
        for (int dh = 0; dh < 2; ++dh)
#pragma unroll
            for (int kk = 0; kk < 2; ++kk) vf[dh][kk] = vn[dh][kk];
        if (kt > 0) {
            const bf16_t* kp = K + (tok0 + k0 - 32 + mk) * SBW + h * HD + hi * 8;
#pragma unroll
            for (int d0 = 0; d0 < 4; ++d0) kn[d0] = *(const bf16x8*)(kp + d0 * 16);
#pragma unroll
            for (int dh = 0; dh < 2; ++dh)
#pragma unroll
                for (int kk = 0; kk < 2; ++kk) vn[dh][kk] = *(const bf16x8*)(vbase + (size_t)dh * 32 * MT + k0 - 32 + 16 * kk);
        }
        f32x16 z;
#pragma unroll
        for (int r = 0; r < 16; ++r) z[r] = 0.f;
#pragma unroll
        for (int d0 = 0; d0 < 4; ++d0) z = __builtin_amdgcn_mfma_f32_32x32x16_bf16(kf[d0], qf[d0], z, 0, 0, 0);
        float L[16]; const int qpos = q0 + n; const bool diag = (kt == qt);
#pragma unroll
        for (int r = 0; r < 16; ++r) {
            const float zz = z[r]; const float e = __expf(-fabsf(zz));
            float l = fminf(-zz, 0.f) - flog1p_(e);
            if (diag) { const int key = k0 + (r & 7) + 8 * hi + 16 * (r >> 3); if (key >= qpos) l = 0.f; }
            L[r] = l;
        }
#pragma unroll
        for (int r = 6; r >= 0; --r) { L[r] += L[r + 1]; L[r + 8] += L[r + 9]; }
        const float sA = L[0], sB = L[8];
        const float pA = __shfl_xor(sA, 32), pB = __shfl_xor(sB, 32);
        const float offA = (hi ? (pB + sB) : (pA + sB + pB)) + C, offB = (hi ? 0.f : pB) + C;
        float w[16];
#pragma unroll
        for (int r = 0; r < 16; ++r) {
            float lw = z[r] + L[r] + (r < 8 ? offA : offB); float e = __expf(lw);
            if (diag) { const int key = k0 + (r & 7) + 8 * hi + 16 * (r >> 3); if (key >= qpos) e = 0.f; }
            w[r] = e;
        }
        C += (sA + sB) + (pA + pB);
        u32x4 w0, w1; w0.x = pkbf(w[0], w[1]); w0.y = pkbf(w[2], w[3]); w0.z = pkbf(w[4], w[5]); w0.w = pkbf(w[6], w[7]);
        w1.x = pkbf(w[8], w[9]); w1.y = pkbf(w[10], w[11]); w1.z = pkbf(w[12], w[13]); w1.w = pkbf(w[14], w[15]);
        const bf16x8 wb0 = __builtin_bit_cast(bf16x8, w0), wb1 = __builtin_bit_cast(bf16x8, w1);
        o0 = __builtin_amdgcn_mfma_f32_32x32x16_bf16(vf[0][0], wb0, o0, 0, 0, 0);
        o0 = __builtin_amdgcn_mfma_f32_32x32x16_bf16(vf[0][1], wb1, o0, 0, 0, 0);
        o1 = __builtin_amdgcn_mfma_f32_32x32x16_bf16(vf[1][0], wb0, o1, 0, 0, 0);
        o1 = __builtin_amdgcn_mfma_f32_32x32x16_bf16(vf[1][1], wb1, o1, 0, 0, 0);
        if (__all(C < -40.f)) break;
    }
    bf16_t* op = O + (tok0 + q0 + n) * SBW + h * HD + 4 * hi;
#pragma unroll
    for (int i = 0; i < 4; ++i) {
        u32x2 a; a.x = pkbf(o0[4 * i], o0[4 * i + 1]); a.y = pkbf(o0[4 * i + 2], o0[4 * i + 3]); *(u32x2*)(op + 8 * i) = a;
        u32x2 c; c.x = pkbf(o1[4 * i], o1[4 * i + 1]); c.y = pkbf(o1[4 * i + 2], o1[4 * i + 3]); *(u32x2*)(op + 32 + 8 * i) = c;
    }
}

constexpr int RW_T = 32;
constexpr int RS1 = 144, RS2 = 272, RS3 = 80;
constexpr int O_WF = 0, O_Y = 0, O_GAM = 8192, O_AT = 16384, O_RT = 20992, O_BT = 25600, O_KT = 30208, O_BTT = 34816, O_KTT = 39936, O_VT = 45056, O_WT = 50176, O_UT = 55296,
              O_LABF = 60416, O_LAK = 64512, O_LRB = 67072, O_LRK = 69632, O_INV = 72192, O_SIMG = 74752, O_GG = 83968, O_W2 = 92160, O_A2 = 101376, O_G2 = 110592, O_CONST = 128000, O_RW_END = 128000 + 4096;
constexpr int O_XW = O_AT, O_XA = O_RT, O_XG = O_BT;
constexpr int O_PW = O_BTT, O_PA = O_BTT + 8192;
static_assert(O_RW_END <= LDS_BYTES && O_XG + 32 * RS2 <= O_BTT && O_PA + 8192 <= O_LABF, "rwkv LDS map");
struct RwParams { const bf16_t* U; const bf16_t* XA; const bf16_t *w2T, *a2T, *g2T; const float *mu, *w0, *a0, *k_k, *k_a, *r_k, *ln_w, *ln_b; bf16_t* O; };

template <int NK> __device__ __forceinline__ f32x16 mm_tile(f32x16 acc, const LAS unsigned char* A, int as, const LAS unsigned char* B, int bs, int lane) {
    const int n = lane & 31, hi = lane >> 5;
#pragma unroll
    for (int kk = 0; kk < NK; ++kk) {
        const bf16x8 af = *(const LAS bf16x8*)(A + n * as + (16 * kk + 8 * hi) * 2);
        const bf16x8 bf = *(const LAS bf16x8*)(B + n * bs + (16 * kk + 8 * hi) * 2);
        acc = __builtin_amdgcn_mfma_f32_32x32x16_bf16(af, bf, acc, 0, 0, 0);
    }
    return acc;
}
__device__ __forceinline__ void store_T_img(const f32x16& acc, LAS unsigned char* img, int col, int hi) {
#pragma unroll
    for (int i = 0; i < 4; ++i) { u32x2 w; w.x = pkbf(acc[4 * i], acc[4 * i + 1]); w.y = pkbf(acc[4 * i + 2], acc[4 * i + 3]); *(LAS u32x2*)(img + col * RS3 + (8 * i + 4 * hi) * 2) = w; }
}
__device__ __forceinline__ f32x16 zero16() { f32x16 z;
#pragma unroll
    for (int r = 0; r < 16; ++r) z[r] = 0.f;
    return z; }

__device__ __forceinline__ void rwkv_unit(const RwParams& P, int bh, LAS unsigned char* lds) {
    const int tid = threadIdx.x, lane = tid & 63, wv = __builtin_amdgcn_readfirstlane(tid >> 6);
    const int b = bh >> 3, h = bh & 7;
    const int tok = tid >> 4, j = tid & 15, c4 = 4 * j;
    const int ln = lane & 31, lhi = lane >> 5;
    LAS float* CST = (LAS float*)(lds + O_CONST);
    __syncthreads();
    {
        const int row = tid >> 3, ch = tid & 7;
        *(LAS u32x4*)(lds + O_W2 + row * RS1 + ch * 16) = *(const u32x4*)(P.w2T + (size_t)(h * HD + row) * 64 + ch * 8);
        *(LAS u32x4*)(lds + O_A2 + row * RS1 + ch * 16) = *(const u32x4*)(P.a2T + (size_t)(h * HD + row) * 64 + ch * 8);
#pragma unroll
        for (int i = 0; i < 2; ++i) { const int id = tid + 512 * i, r2 = id >> 4, c2 = id & 15;
            *(LAS u32x4*)(lds + O_G2 + r2 * RS2 + c2 * 16) = *(const u32x4*)(P.g2T + (size_t)(h * HD + r2) * 128 + c2 * 8); }
        if (tid < 64) { CST[tid] = P.mu[h * HD + tid]; CST[64 + tid] = P.mu[512 + h * HD + tid]; CST[128 + tid] = P.mu[1024 + h * HD + tid];
            CST[448 + tid] = P.w0[h * HD + tid]; CST[512 + tid] = P.a0[h * HD + tid]; CST[576 + tid] = P.k_k[h * HD + tid]; CST[640 + tid] = P.k_a[h * HD + tid];
            CST[704 + tid] = P.r_k[h * HD + tid]; CST[768 + tid] = P.ln_w[h * HD + tid]; CST[832 + tid] = P.ln_b[h * HD + tid]; }
        if (tid < 256) CST[192 + tid] = P.mu[1536 + tid];
        for (int i = tid; i < 9216 / 16; i += 512) *(LAS u32x4*)(lds + O_SIMG + i * 16) = (u32x4){0u, 0u, 0u, 0u};
    }
    __syncthreads();
    f32x16 St = zero16();
    const bf16_t* Ub = P.U + (size_t)b * SEQ * RWC;
    bf16_t* Ob = P.O + (size_t)b * SEQ * RWW + h * HD + c4;

    u32x2 cr, ck, cv, pr, pk, pv; u32x4 cx0, cx1;
    const bf16_t* Xb = P.XA + (size_t)b * SEQ * 256 + 16 * j;
#define RW_LOAD(c) do { const int t_ = (c) * RW_T + tok; const bf16_t* rp = Ub + (size_t)t_ * RWC; \
        cr = *(const u32x2*)(rp + h * HD + c4); ck = *(const u32x2*)(rp + 512 + h * HD + c4); cv = *(const u32x2*)(rp + 1024 + h * HD + c4); \
        cx0 = *(const u32x4*)(Xb + (size_t)t_ * 256); cx1 = *(const u32x4*)(Xb + (size_t)t_ * 256 + 8); \
        if (t_ > 0) { const bf16_t* qp = rp - RWC; pr = *(const u32x2*)(qp + h * HD + c4); pk = *(const u32x2*)(qp + 512 + h * HD + c4); pv = *(const u32x2*)(qp + 1024 + h * HD + c4); } \
        else { pr = (u32x2){0u, 0u}; pk = pr; pv = pr; } } while (0)
    RW_LOAD(0);
    u32x2 wout = {0u, 0u};
    for (int c = 0; c < SEQ / RW_T; ++c) {
        float rr[4], kx[4], vx[4];
        {
            const float cr_[4] = {bflo(cr.x), bfhi(cr.x), bflo(cr.y), bfhi(cr.y)}, pr_[4] = {bflo(pr.x), bfhi(pr.x), bflo(pr.y), bfhi(pr.y)};
            const float ck_[4] = {bflo(ck.x), bfhi(ck.x), bflo(ck.y), bfhi(ck.y)}, pk_[4] = {bflo(pk.x), bfhi(pk.x), bflo(pk.y), bfhi(pk.y)};
            const float cv_[4] = {bflo(cv.x), bfhi(cv.x), bflo(cv.y), bfhi(cv.y)}, pv_[4] = {bflo(pv.x), bfhi(pv.x), bflo(pv.y), bfhi(pv.y)};
            const f32x4 mr = *(const LAS f32x4*)(CST + c4), mk = *(const LAS f32x4*)(CST + 64 + c4), mv = *(const LAS f32x4*)(CST + 128 + c4);
#pragma unroll
            for (int i = 0; i < 4; ++i) { rr[i] = cr_[i] + (pr_[i] - cr_[i]) * mr[i]; kx[i] = ck_[i] + (pk_[i] - ck_[i]) * mk[i]; vx[i] = cv_[i] + (pv_[i] - cv_[i]) * mv[i]; }
            LAS unsigned char* dst = (j < 4) ? lds + O_XW + tok * RS1 + j * 32 : (j < 8) ? lds + O_XA + tok * RS1 + (j - 4) * 32 : lds + O_XG + tok * RS2 + (j - 8) * 32;
            *(LAS u32x4*)dst = cx0; *(LAS u32x4*)(dst + 16) = cx1;
        }
        if (c > 0) *(u32x2*)(Ob + (size_t)((c - 1) * RW_T + tok) * RWW) = wout;
        __syncthreads();
        if (wv < 6) {
            const int prod = wv >> 1, nt = wv & 1;
            const int xo = prod == 0 ? O_XW : (prod == 1 ? O_XA : O_XG), wo = prod == 0 ? O_W2 : (prod == 1 ? O_A2 : O_G2), rs = prod == 2 ? RS2 : RS1, nk = prod == 2 ? 8 : 4;
            const int po = prod == 0 ? O_PW : (prod == 1 ? O_PA : O_GG);
            f32x16 acc = zero16();
            for (int kk = 0; kk < nk; ++kk) {
                const bf16x8 af = *(const LAS bf16x8*)(lds + xo + ln * rs + (16 * kk + 8 * lhi) * 2);
                const bf16x8 bf = *(const LAS bf16x8*)(lds + wo + (32 * nt + ln) * rs + (16 * kk + 8 * lhi) * 2);
                acc = __builtin_amdgcn_mfma_f32_32x32x16_bf16(af, bf, acc, 0, 0, 0);
            }
            LAS float* pd = (LAS float*)(lds + po) + 32 * nt + ln;
#pragma unroll
            for (int r = 0; r < 16; ++r) pd[((r & 3) + 8 * (r >> 2) + 4 * lhi) * 64] = acc[r];
        }
        __syncthreads();
        float bonus; f32x4 av, nkk, bb, kef;
        {
            const f32x4 wp = *(const LAS f32x4*)(lds + O_PW + (tok * 64 + c4) * 4), ap = *(const LAS f32x4*)(lds + O_PA + (tok * 64 + c4) * 4);
            const f32x4 w0 = *(const LAS f32x4*)(CST + 448 + c4), a0 = *(const LAS f32x4*)(CST + 512 + c4), k_k = *(const LAS f32x4*)(CST + 576 + c4), k_a = *(const LAS f32x4*)(CST + 640 + c4), r_k = *(const LAS f32x4*)(CST + 704 + c4);
            f32x4 dec, kkv; float n2 = 0.f, bs = 0.f;
#pragma unroll
            for (int i = 0; i < 4; ++i) {
                const float xw = -(w0[i] + wp[i]);
                const float sp = fmaxf(xw, 0.f) + flog1p_(__expf(-fabsf(xw)));
                dec[i] = __expf(-__expf(-sp - 0.5f));
                av[i] = sigm(a0[i] + ap[i]);
                kkv[i] = kx[i] * k_k[i]; n2 += kkv[i] * kkv[i];
                kef[i] = kx[i] * (1.f + (av[i] - 1.f) * k_a[i]);
                bs += rr[i] * kef[i] * r_k[i];
            }
            n2 = red16(n2); bonus = red16(bs);
            const float inv = fminf(rsqrtf(n2), 1e12f);
#pragma unroll
            for (int i = 0; i < 4; ++i) { const float kn = kkv[i] * inv; nkk[i] = -kn; bb[i] = kn * av[i]; }
            *(LAS f32x4*)(lds + O_WF + (tok * 64 + c4) * 4) = dec;
        }
        if (c + 1 < SEQ / RW_T) RW_LOAD(c + 1);
        __syncthreads();
        if (wv == 0) {
            float wv_[RW_T];
#pragma unroll
            for (int t = 0; t < RW_T; ++t) wv_[t] = *(const LAS float*)(lds + O_WF + (t * 64 + lane) * 4);
            float g = 1.f;
#pragma unroll
            for (int t = 0; t < RW_T; ++t) { g *= wv_[t]; *(LAS float*)(lds + O_GAM + (t * 64 + lane) * 4) = g; }
        }
        __syncthreads();
        {
            const f32x4 gt = *(const LAS f32x4*)(lds + O_GAM + (tok * 64 + c4) * 4);
            f32x4 gp = {1.f, 1.f, 1.f, 1.f}; if (tok > 0) gp = *(const LAS f32x4*)(lds + O_GAM + ((tok - 1) * 64 + c4) * 4);
            float at[4], rt[4], bt[4], kt[4];
#pragma unroll
            for (int i = 0; i < 4; ++i) { const float ig = __builtin_amdgcn_rcpf(gt[i]); at[i] = gp[i] * nkk[i]; rt[i] = gt[i] * rr[i]; bt[i] = bb[i] * ig; kt[i] = kef[i] * ig; }
            u32x2 w;
            w.x = pkbf(at[0], at[1]); w.y = pkbf(at[2], at[3]); *(LAS u32x2*)(lds + O_AT + tok * RS1 + c4 * 2) = w;
            w.x = pkbf(rt[0], rt[1]); w.y = pkbf(rt[2], rt[3]); *(LAS u32x2*)(lds + O_RT + tok * RS1 + c4 * 2) = w;
            w.x = pkbf(bt[0], bt[1]); w.y = pkbf(bt[2], bt[3]); *(LAS u32x2*)(lds + O_BT + tok * RS1 + c4 * 2) = w;
            w.x = pkbf(kt[0], kt[1]); w.y = pkbf(kt[2], kt[3]); *(LAS u32x2*)(lds + O_KT + tok * RS1 + c4 * 2) = w;
#pragma unroll
            for (int i = 0; i < 4; ++i) {
                *(LAS bf16_t*)(lds + O_BTT + (c4 + i) * RS3 + tok * 2) = (bf16_t)(pkbf(bt[i], 0.f) & 0xffffu);
                *(LAS bf16_t*)(lds + O_KTT + (c4 + i) * RS3 + tok * 2) = (bf16_t)(pkbf(kt[i], 0.f) & 0xffffu);
                *(LAS bf16_t*)(lds + O_VT + (c4 + i) * RS3 + tok * 2) = (bf16_t)(pkbf(vx[i], 0.f) & 0xffffu);
            }
        }
        __syncthreads();
        f32x16 acc = zero16();
        if (wv == 0) {
            const f32x16 l = mm_tile<4>(zero16(), lds + O_AT, RS1, lds + O_BT, RS1, lane);
#pragma unroll
            for (int r = 0; r < 16; ++r) { const int t = (r & 3) + 8 * (r >> 2) + 4 * lhi; *(LAS float*)(lds + O_LABF + (t * 32 + ln) * 4) = (ln < t) ? l[r] : 0.f; }
        } else if (wv == 1) {
            const f32x16 l = mm_tile<4>(zero16(), lds + O_RT, RS1, lds + O_BT, RS1, lane);
#pragma unroll
            for (int r = 0; r < 16; ++r) { const int t = (r & 3) + 8 * (r >> 2) + 4 * lhi; *(LAS bf16_t*)(lds + O_LRB + t * RS3 + ln * 2) = (bf16_t)(pkbf((ln <= t) ? l[r] : 0.f, 0.f) & 0xffffu); }
        } else if (wv >= 4) {
            const int incl = (wv >= 6);
            const f32x16 l = mm_tile<4>(zero16(), lds + (wv < 6 ? O_AT : O_RT), RS1, lds + O_KT, RS1, lane);
            LAS unsigned char* ld = lds + (wv < 6 ? O_LAK : O_LRK) + ln * 2;
#pragma unroll
            for (int r = 0; r < 16; ++r) { const int t = (r & 3) + 8 * (r >> 2) + 4 * lhi; *(LAS bf16_t*)(ld + t * RS3) = (bf16_t)(pkbf((ln < t + incl) ? l[r] : 0.f, 0.f) & 0xffffu); }
            acc = mm_tile<4>(acc, lds + (wv < 6 ? O_AT : O_RT), RS1, lds + O_SIMG + 32 * (wv & 1) * RS1, RS1, lane);
        }
        for (int irep = 0; irep < (PROBE_PHASE == 30 ? 2 : 1); ++irep)
        if (wv == 0) {
            float x[16]; const int blk = (lane >> 4) & 1, lc = lane & 15;
            const LAS unsigned char* lrow = lds + O_LABF + ((16 * blk) * 32 + 16 * blk + lc) * 4;
            x[0] = (lc == 0) ? 1.f : 0.f;
#define RW_FD(acc_, lv_, xv_, n_) asm("v_fmac_f32_dpp %0, %1, %2 row_newbcast:" #n_ " row_mask:0xf bank_mask:0xf" : "+v"(acc_) : "v"(lv_), "v"(xv_))
#define RW_T1(acc_, la_, jq) do { switch (jq) { \
        case 0: RW_FD(acc_, la_, x[jq], 0); break; case 1: RW_FD(acc_, la_, x[jq], 1); break; case 2: RW_FD(acc_, la_, x[jq], 2); break; case 3: RW_FD(acc_, la_, x[jq], 3); break; \
        case 4: RW_FD(acc_, la_, x[jq], 4); break; case 5: RW_FD(acc_, la_, x[jq], 5); break; case 6: RW_FD(acc_, la_, x[jq], 6); break; case 7: RW_FD(acc_, la_, x[jq], 7); break; \
        case 8: RW_FD(acc_, la_, x[jq], 8); break; case 9: RW_FD(acc_, la_, x[jq], 9); break; case 10: RW_FD(acc_, la_, x[jq], 10); break; case 11: RW_FD(acc_, la_, x[jq], 11); break; \
        case 12: RW_FD(acc_, la_, x[jq], 12); break; case 13: RW_FD(acc_, la_, x[jq], 13); break; case 14: RW_FD(acc_, la_, x[jq], 14); break; default: RW_FD(acc_, la_, x[jq], 15); break; } } while (0)
#define RW_T2(t, jq) do { if ((jq) < (t)) { RW_T1(sa, la0, jq); RW_T1(sb, la1, jq); } } while (0)
#pragma unroll
            for (int t = 1; t < 16; t += 2) {
                const int t1 = (t + 1 < 16) ? t + 1 : t;
                float sa = (t == lc) ? 1.f : 0.f, sb = (t1 == lc) ? 1.f : 0.f;
                const float la0 = *(const LAS float*)(lrow + t * 128), la1 = *(const LAS float*)(lrow + t1 * 128);
                RW_T2(t, 0); RW_T2(t, 1); RW_T2(t, 2); RW_T2(t, 3); RW_T2(t, 4); RW_T2(t, 5); RW_T2(t, 6); RW_T2(t, 7); RW_T2(t, 8); RW_T2(t, 9); RW_T2(t, 10); RW_T2(t, 11); RW_T2(t, 12); RW_T2(t, 13); RW_T2(t, 14);
                x[t] = sa;
                if (t + 1 < 16) { RW_T1(sb, la1, t); x[t + 1] = sb; }
            }
#undef RW_T2
#undef RW_T1
#undef RW_FD
            if (lhi == 0) {
#pragma unroll
                for (int t = 0; t < 16; ++t) { *(LAS bf16_t*)(lds + O_INV + (16 * blk + t) * RS3 + (16 * blk + lc) * 2) = (bf16_t)(pkbf(x[t], 0.f) & 0xffffu);
                    if (blk) *(LAS bf16_t*)(lds + O_INV + t * RS3 + (16 + lc) * 2) = (bf16_t)0; }
            }
            bf16x8 fa, fb; const bool lo16 = (ln < 16);
            {
                const f32x4 c0 = *(const LAS f32x4*)(lds + O_LABF + ((16 + (ln & 15)) * 32 + 8 * lhi) * 4), c1 = *(const LAS f32x4*)(lds + O_LABF + ((16 + (ln & 15)) * 32 + 8 * lhi + 4) * 4);
                u32x4 wa = {pkbf(c0[0], c0[1]), pkbf(c0[2], c0[3]), pkbf(c1[0], c1[1]), pkbf(c1[2], c1[3])}; if (!lo16) wa = (u32x4){0u, 0u, 0u, 0u};
                fa = __builtin_bit_cast(bf16x8, wa);
                float xs[8]; int hm = -lhi; asm volatile("" : "+v"(hm));
#pragma unroll
                for (int e = 0; e < 8; ++e) xs[e] = __int_as_float((__float_as_int(x[8 + e]) & hm) | (__float_as_int(x[e]) & ~hm));
                u32x4 wb = {pkbf(xs[0], xs[1]), pkbf(xs[2], xs[3]), pkbf(xs[4], xs[5]), pkbf(xs[6], xs[7])}; if (!lo16) wb = (u32x4){0u, 0u, 0u, 0u};
                fb = __builtin_bit_cast(bf16x8, wb);
            }
            f32x16 pm_ = __builtin_amdgcn_mfma_f32_32x32x16_bf16(fa, fb, zero16(), 0, 0, 0);
            {
                u32x4 wb = {pkbf(pm_[0], pm_[1]), pkbf(pm_[2], pm_[3]), pkbf(pm_[4], pm_[5]), pkbf(pm_[6], pm_[7])};
                fb = __builtin_bit_cast(bf16x8, wb);
                const LAS unsigned char* dr = lds + O_INV + (16 + (ln & 15)) * RS3 + (16 + 4 * lhi) * 2;
                const u32x2 d0 = *(const LAS u32x2*)dr, d1 = *(const LAS u32x2*)(dr + 16);
                u32x4 wa = {d0.x, d0.y, d1.x, d1.y}; if (!lo16) wa = (u32x4){0u, 0u, 0u, 0u};
                fa = __builtin_bit_cast(bf16x8, wa);
            }
            pm_ = __builtin_amdgcn_mfma_f32_32x32x16_bf16(fa, fb, zero16(), 0, 0, 0);
            if (lo16) {
#pragma unroll
                for (int r = 0; r < 8; ++r) *(LAS bf16_t*)(lds + O_INV + (16 + (r & 3) + 8 * (r >> 2) + 4 * lhi) * RS3 + ln * 2) = (bf16_t)(pkbf(pm_[r], 0.f) & 0xffffu);
            }
        } else if (wv >= 4 && irep == 0) {
            acc = mm_tile<2>(acc, lds + (wv < 6 ? O_LAK : O_LRK), RS3, lds + O_VT + 32 * (wv & 1) * RS3, RS3, lane);
            if (wv < 6) store_T_img(acc, lds + O_WT, 32 * (wv & 1) + ln, lhi);
        }
        __syncthreads();
        if (wv < 4 || wv >= 6) {
            f32x16 u = zero16();
            u = mm_tile<2>(u, lds + O_INV, RS3, lds + O_WT + 32 * (wv & 1) * RS3, RS3, lane);
            store_T_img(u, lds + O_UT, 32 * (wv & 1) + ln, lhi);
        }
        if (wv >= 6) {
            acc = mm_tile<2>(acc, lds + O_LRB, RS3, lds + O_UT + 32 * (wv & 1) * RS3, RS3, lane);
            LAS float* yd = (LAS float*)(lds + O_Y) + 32 * (wv & 1) + ln;
#pragma unroll
            for (int r = 0; r < 16; ++r) yd[((r & 3) + 8 * (r >> 2) + 4 * lhi) * 64] = acc[r];
        } else if (wv < 4) {
            const int kt = wv >> 1, vt = wv & 1;
            St = mm_tile<2>(St, lds + O_BTT + 32 * kt * RS3, RS3, lds + O_UT + 32 * vt * RS3, RS3, lane);
            St = mm_tile<2>(St, lds + O_KTT + 32 * kt * RS3, RS3, lds + O_VT + 32 * vt * RS3, RS3, lane);
#pragma unroll
            for (int i = 0; i < 4; ++i) {
                const f32x4 g4 = *(const LAS f32x4*)(lds + O_GAM + ((RW_T - 1) * 64 + 32 * kt + 8 * i + 4 * lhi) * 4);
#pragma unroll
                for (int e = 0; e < 4; ++e) St[4 * i + e] *= g4[e];
                u32x2 w; w.x = pkbf(St[4 * i], St[4 * i + 1]); w.y = pkbf(St[4 * i + 2], St[4 * i + 3]);
                *(LAS u32x2*)(lds + O_SIMG + (32 * vt + ln) * RS1 + (32 * kt + 8 * i + 4 * lhi) * 2) = w;
            }
        }
        __syncthreads();
        {
            const f32x4 y = *(const LAS f32x4*)(lds + O_Y + (tok * 64 + c4) * 4), g = *(const LAS f32x4*)(lds + O_GG + (tok * 64 + c4) * 4);
            const f32x4 lw = *(const LAS f32x4*)(CST + 768 + c4), lb = *(const LAS f32x4*)(CST + 832 + c4);
            const float mu = red16((y[0] + y[1]) + (y[2] + y[3])) * (1.f / 64.f);
            const f32x4 d = y - mu;
            const float var = red16((d[0] * d[0] + d[1] * d[1]) + (d[2] * d[2] + d[3] * d[3])) * (1.f / 64.f);
            const float rs = rsqrtf(var + 64e-5f);
            float o[4];
#pragma unroll
            for (int i = 0; i < 4; ++i) o[i] = ((d[i] * rs) * lw[i] + lb[i] + bonus * vx[i]) * g[i];
            wout.x = pkbf(o[0], o[1]); wout.y = pkbf(o[2], o[3]);
        }
    }
    *(u32x2*)(Ob + (size_t)(SEQ - RW_T + tok) * RWW) = wout;
#undef RW_LOAD
    __syncthreads();
}

#define XB_TMO      128
#define XB_XCNT(j)  (256  + 64 * (j))
#define XB_XSUB(j)  (1280 + 64 * (j))
#define XB_XGEN(j)  (2304 + 64 * (j))
#define XB_TOP      3328
#define XB_TOPGEN   3392
#define XCD_BAR_WORDS 3456
#define XB_SPIN_CAP (1u << 18)

__device__ __forceinline__ unsigned xb_ld(unsigned* p)              { return __hip_atomic_load(p, __ATOMIC_RELAXED, __HIP_MEMORY_SCOPE_AGENT); }
__device__ __forceinline__ unsigned xb_add(unsigned* p, unsigned v) { return __hip_atomic_fetch_add(p, v, __ATOMIC_RELAXED, __HIP_MEMORY_SCOPE_AGENT); }
__device__ __forceinline__ unsigned xb_xcc_id() { return (unsigned)__builtin_amdgcn_s_getreg((3 << 11) | 20) & 0xFu; }
#define XB_SPIN(cond, bar) do { unsigned _sp = 0; while (cond) { __builtin_amdgcn_s_sleep(1); \
    if ((++_sp & 255u) == 0u) { if (xb_ld(&(bar)[XB_TMO])) break; if (_sp > XB_SPIN_CAP) { atomicAdd(&(bar)[XB_TMO], 1u); break; } } } } while (0)

struct XcdBarrier {
    unsigned* bar; unsigned x;
    volatile LAS unsigned* st;
};

__device__ __forceinline__ XcdBarrier xcd_barrier_post(unsigned* bar, volatile LAS unsigned* st) {
    XcdBarrier b; b.bar = bar; b.x = xb_xcc_id(); b.st = st;
    if (threadIdx.x == 0) (void)xb_add(&bar[XB_XCNT(b.x)], 1u);
    return b;
}
__device__ __forceinline__ void xcd_barrier_complete(unsigned* bar, unsigned x, unsigned& nloc, unsigned& nx) {
    const unsigned G = gridDim.x * gridDim.y * gridDim.z;
    unsigned sum, cnt, mine, sp = 0u;
    for (;;) {
        sum = 0u; cnt = 0u; mine = 0u;
#pragma unroll
        for (unsigned j = 0; j < 16; ++j) { const unsigned c = xb_ld(&bar[XB_XCNT(j)]); sum += c; cnt += (c > 0u) ? 1u : 0u; mine = (j == x) ? c : mine; }
        if (sum == G) break;
        __builtin_amdgcn_s_sleep(1);
        if ((++sp & 255u) == 0u) { if (xb_ld(&bar[XB_TMO])) break; if (sp > XB_SPIN_CAP) { atomicAdd(&bar[XB_TMO], 1u); break; } }
    }
    nloc = mine > 0u ? mine : 1u; nx = cnt > 0u ? cnt : 1u;
}

__device__ __forceinline__ void xcd_barrier(const XcdBarrier& b) {
    asm volatile("s_waitcnt vmcnt(0)" ::: "memory");
    __syncthreads();
    if (threadIdx.x == 0) {
        unsigned* bar = b.bar;
        __builtin_amdgcn_s_waitcnt(0);
        unsigned nloc = b.st[0], nx = b.st[1];
        if (nloc == 0u) { xcd_barrier_complete(bar, b.x, nloc, nx); b.st[0] = nloc; b.st[1] = nx; }
        const unsigned old = xb_add(&bar[XB_XSUB(b.x)], 1u);
        const unsigned gen = old / nloc;
        if (old + 1u == (gen + 1u) * nloc) {
            __builtin_amdgcn_fence(__ATOMIC_RELEASE, "agent");
            asm volatile("s_waitcnt vmcnt(0)" ::: "memory");
            const unsigned og = xb_add(&bar[XB_TOP], 1u);
            const unsigned tg = og / nx;
            if (og + 1u == (tg + 1u) * nx) xb_add(&bar[XB_TOPGEN], 1u);
            else XB_SPIN(xb_ld(&bar[XB_TOPGEN]) == tg, bar);
            __builtin_amdgcn_fence(__ATOMIC_ACQUIRE, "agent");
            xb_add(&bar[XB_XGEN(b.x)], 1u);
            asm volatile("s_waitcnt vmcnt(0)" ::: "memory");
        } else {
            XB_SPIN(xb_ld(&bar[XB_XGEN(b.x)]) == gen, bar);
            __builtin_amdgcn_fence(__ATOMIC_ACQUIRE, "agent");
            asm volatile("s_waitcnt vmcnt(0)" ::: "memory");
        }
    }
    __syncthreads();
}

struct Args { const float* in[25]; float* out; unsigned char* ws; int ph_lo, ph_hi; };
enum { I_X = 0, I_P, I_ANG, I_WIN, I_MU, I_W0, I_W2, I_A0, I_A2, I_G2, I_KK, I_KA, I_RK, I_LNW, I_LNB, I_WSB, I_WRW, I_WOUT, I_MNG, I_FF1, I_FF2, I_PNG, I_WPG, I_WPP, I_FNG };

__global__ void __attribute__((target("no-packed-fp32-ops"))) __launch_bounds__(512, 2) fwd_mega(Args a) {
    extern __shared__ __attribute__((aligned(16))) unsigned char lds_raw[];
    LAS unsigned char* lds = (LAS unsigned char*)lds_raw;
    cg::grid_group grid = cg::this_grid();
    const int tid = threadIdx.x, lane = tid & 63, wave = __builtin_amdgcn_readfirstlane(tid >> 6);
    const int G = gridDim.x, gw = blockIdx.x * 8 + wave, NGW = G * 8;
    unsigned char* ws = a.ws;
    bf16_t *WinT = (bf16_t*)(ws + WS_WIN), *WsbT = (bf16_t*)(ws + WS_WSB), *WrwT = (bf16_t*)(ws + WS_WRW), *WoutT = (bf16_t*)(ws + WS_WOUT), *W1T = (bf16_t*)(ws + WS_W1), *W2T = (bf16_t*)(ws + WS_W2),
           *WgT = (bf16_t*)(ws + WS_WG), *WpT = (bf16_t*)(ws + WS_WP), *Lw2T = (bf16_t*)(ws + WS_LW2), *La2T = (bf16_t*)(ws + WS_LA2), *Lg2T = (bf16_t*)(ws + WS_LG2);
    bf16_t *PB = (bf16_t*)(ws + WS_PB), *H = (bf16_t*)(ws + WS_H), *Qb = (bf16_t*)(ws + WS_Q), *Kb = (bf16_t*)(ws + WS_K), *Vt = (bf16_t*)(ws + WS_VT), *U = (bf16_t*)(ws + WS_U), *GT = (bf16_t*)(ws + WS_G),
           *Osb = (bf16_t*)(ws + WS_OSB), *Orw = (bf16_t*)(ws + WS_ORW), *Fb = (bf16_t*)(ws + WS_F), *TMP = (bf16_t*)(ws + WS_TMP);
    bf16_t* MG = H; bf16_t* XB1 = Osb; bf16_t* XACT = H;
    unsigned* CNT = (unsigned*)(ws + 832 * 1024);
    float *SS1 = (float*)ws, *SS2 = SS1 + MT, *SS3 = SS2 + MT;
    float* X = a.out;
#define IN(k) (a.ph_lo <= (k) && (k) < a.ph_hi)
#define REP(k) for (int rep_ = 0; rep_ < ((k) == PROBE_PHASE ? 2 : 1); ++rep_)
#define SEAM(k) do { if (a.ph_lo <= (k) && (k) + 1 < a.ph_hi) { if ((k) == 0) grid.sync(); else xcd_barrier(xbar); } } while (0)
    volatile LAS unsigned* xst = (volatile LAS unsigned*)(lds + LDS_BYTES - 64);
    if (tid == 0) { xst[0] = 0u; xst[1] = 0u; }
    __syncthreads();
    const XcdBarrier xbar = xcd_barrier_post((unsigned*)(ws + WS_XBAR), xst);

    if (IN(0)) REP(0) {
        LAS float* scr = (LAS float*)(lds + wave * 16384);
        constexpr int I0 = 16 * 168, I1 = 8 * 32, I2 = 8 * 32, I3 = 16 * 32, I4 = 16 * 128, I5 = 64 * 32, I6 = 16 * 32, I7 = 4 * 32, I8 = 16, I9 = 16, I10 = 32;
        constexpr int NIT = I0 + I1 + I2 + I3 + I4 + I5 + I6 + I7 + I8 + I9 + I10;
        for (int it = gw; it < NIT; it += NGW) {
            int r = it;
            if (r < I0) { const int kb = r / 168, nb = r % 168; transpose_item(a.in[I_WIN], DM, INC, WinT, 64 * kb, 32 * nb, win_dst(32 * nb), scr, lane); continue; } r -= I0;
            if (r < I1) { const int kb = r / 32, nb = r % 32; transpose_item(a.in[I_WSB], SBW, DM, WsbT, 64 * kb, 32 * nb, 32 * nb, scr, lane); continue; } r -= I1;
            if (r < I2) { const int kb = r / 32, nb = r % 32; transpose_item(a.in[I_WRW], RWW, DM, WrwT, 64 * kb, 32 * nb, 32 * nb, scr, lane); continue; } r -= I2;
            if (r < I3) { const int kb = r / 32, nb = r % 32; transpose_item(a.in[I_WOUT], DM, DM, WoutT, 64 * kb, 32 * nb, 32 * nb, scr, lane); continue; } r -= I3;
            if (r < I4) { const int kb = r / 128, nb = r % 128; transpose_item(a.in[I_FF1], DM, FF, W1T, 64 * kb, 32 * nb, 32 * nb, scr, lane, a.in[I_MNG]); continue; } r -= I4;
            if (r < I5) { const int kb = r / 32, nb = r % 32; transpose_item(a.in[I_FF2], FF, DM, W2T, 64 * kb, 32 * nb, 32 * nb, scr, lane); continue; } r -= I5;
            if (r < I6) { const int kb = r / 32, nb = r % 32; transpose_item(a.in[I_WPG], DM, DM, WgT, 64 * kb, 32 * nb, 32 * nb, scr, lane, a.in[I_PNG]); continue; } r -= I6;
            if (r < I7) { const int kb = r / 32, nb = r % 32; transpose_item(a.in[I_WPP], PLE, DM, WpT, 64 * kb, 32 * nb, 32 * nb, scr, lane); continue; } r -= I7;
            if (r < I8) { transpose_item(a.in[I_W2], 64, RWW, Lw2T, 0, 32 * r, 32 * r, scr, lane); continue; } r -= I8;
            if (r < I9) { transpose_item(a.in[I_A2], 64, RWW, La2T, 0, 32 * r, 32 * r, scr, lane); continue; } r -= I9;
            { const int kb = r / 16, nb = r % 16; transpose_item(a.in[I_G2], 128, RWW, Lg2T, 64 * kb, 32 * nb, 32 * nb, scr, lane); }
        }
        for (int m = gw; m < MT; m += NGW) rms_row_bf16(a.in[I_X] + (size_t)m * DM, a.in[I_ANG], H + (size_t)m * DM, lane);
        for (int i = blockIdx.x * 512 + tid; i < 3 * MT; i += G * 512) SS1[i] = 0.f;
        for (int i = blockIdx.x * 512 + tid; i < 64 * 256; i += G * 512) CNT[i] = 0u;
        {
            const f32x4* src = (const f32x4*)a.in[I_P]; u32x4* dst = (u32x4*)PB; const size_t n8 = (size_t)MT * PLE / 8;
            for (size_t i = (size_t)blockIdx.x * 512 + tid; i < n8; i += (size_t)G * 512) { const f32x4 v0 = src[2 * i], v1 = src[2 * i + 1]; dst[i] = pack8(v0, v1); }
        }
    }
    SEAM(0);
    if (IN(1)) REP(1) {
        run_gemm(lds, H, WinT, MT, NMAIN, DM, FInproj{Qb, Kb, U, GT});
        run_gemm(lds, WinT + (size_t)NMAIN * DM, H, SBW, MT, DM, FStore{Vt, MT});
    }
    SEAM(1);
    if (IN(2)) {
        const float* mu = a.in[I_MU] + 1536;
        for (int it = blockIdx.x * 512 + tid; it < MT * 32; it += G * 512) {
            const int m = it >> 5, c8 = (it & 31) * 8; const bf16_t* rp = U + (size_t)m * RWC + 1536 + c8;
            const u32x4 cw = *(const u32x4*)rp; u32x4 pw = {0u, 0u, 0u, 0u}; if ((m & (SEQ - 1)) != 0) pw = *(const u32x4*)(rp - RWC);
            const f32x4 m0 = *(const f32x4*)(mu + c8), m1 = *(const f32x4*)(mu + c8 + 4);
            f32x4 c0, c1, p0, p1; unpack8(cw, c0, c1); unpack8(pw, p0, p1);
            f32x4 x0 = c0 + (p0 - c0) * m0, x1 = c1 + (p1 - c1) * m1;
            if (c8 < 64) {
#pragma unroll
                for (int e = 0; e < 4; ++e) { x0[e] = 1.f - 2.f * __builtin_amdgcn_rcpf(1.f + __expf(2.f * x0[e])); x1[e] = 1.f - 2.f * __builtin_amdgcn_rcpf(1.f + __expf(2.f * x1[e])); }
            } else if (c8 >= 128) { x0 = sigm4(x0); x1 = sigm4(x1); }
            *(u32x4*)(XACT + (size_t)m * 256 + c8) = pack8(x0, x1);
        }
    }
    if (IN(2)) REP(2) {
        for (int u = gw; u < NB * NH * (SEQ / 32); u += NGW) sb_attn_unit(Qb, Kb, Vt, Osb, u >> 6, u & 63, lane);
        if (a.ph_hi - a.ph_lo > 1) xcd_barrier(xbar);
        RwParams P{U, XACT, Lw2T, La2T, Lg2T, a.in[I_MU], a.in[I_W0], a.in[I_A0], a.in[I_KK], a.in[I_KA], a.in[I_RK], a.in[I_LNW], a.in[I_LNB], Orw};
        for (int bh = blockIdx.x; bh < NB * NH; bh += G) rwkv_unit(P, bh, lds);
    }
    SEAM(2);
    if (IN(3)) REP(3) {
        run_gemm<false>(lds, Osb, WsbT, MT, DM, SBW, FMergeA{GT, MG});
        run_gemm<false>(lds, Orw, WrwT, MT, DM, RWW, FMergeB{GT, MG});
    }
    SEAM(3);
    if (IN(4)) REP(4) run_gemm(lds, MG, WoutT, MT, DM, DM, FRes4{a.in[I_X], XB1, SS1});
    SEAM(4);
    if (IN(6)) REP(6) run_gemm(lds, XB1, W1T, MT, FF, DM, FRelu2{Fb, SS1});
    SEAM(6);
    if (IN(7)) run_gemm(lds, Fb, W2T, MT, DM, FF, FRes7{XB1, H, SS2});
    SEAM(7);
    if (IN(9)) {
        run_gemm<false>(lds, PB, WpT, MT, DM, PLE, FStore{TMP, DM});
        {
            pg8::Gemm g{H, WgT, MT, DM, DM}; const pg8::StaticOrder S{MT / 256, DM / 256, (MT / 256) * (DM / 256), (int)gridDim.x, (int)blockIdx.x};
            EpiPleFinal E{TMP, H, X, SS2, SS3, CNT, a.in[I_FNG]};
            pg8::gemm_phase<EpiPleFinal, pg8::StaticOrder, true, true>(lds, g, S, E);
        }
    }
#undef IN
#undef SEAM
}

extern "C" void kernel_launch(void* const* d_in, const int* in_sizes, int n_in, void* d_out, int out_size, void* d_ws, size_t ws_size, hipStream_t stream) {
    static int grid = 0;
    if (grid == 0) {
        if (n_in != 25 || in_sizes[0] != MT * DM || out_size != MT * DM || ws_size < WS_END) { fprintf(stderr, "kernel_launch: unexpected shapes (n_in %d, in0 %d, out %d, ws %zu); nothing launched\n", n_in, n_in > 0 ? in_sizes[0] : -1, out_size, ws_size); grid = -1; return; }
        int dev = 0, cus = 0, per_cu = 0;
        if (hipGetDevice(&dev) != hipSuccess || hipDeviceGetAttribute(&cus, hipDeviceAttributeMultiprocessorCount, dev) != hipSuccess) { grid = -1; return; }
        if (hipFuncSetAttribute((const void*)fwd_mega, hipFuncAttributeMaxDynamicSharedMemorySize, LDS_BYTES) != hipSuccess) { fprintf(stderr, "kernel_launch: hipFuncSetAttribute failed\n"); grid = -1; return; }
        if (hipOccupancyMaxActiveBlocksPerMultiprocessor(&per_cu, (const void*)fwd_mega, 512, LDS_BYTES) != hipSuccess || per_cu < 1) { fprintf(stderr, "kernel_launch: occupancy query says %d blocks per CU\n", per_cu); per_cu = 1; }
        (void)hipGetLastError();
        grid = cus;
    }
    if (grid < 0) return;
    Args a{};
    for (int i = 0; i < 25; ++i) a.in[i] = (const float*)d_in[i];
    a.out = (float*)d_out; a.ws = (unsigned char*)d_ws;
#if MK_ONE_LAUNCH
    if (hipMemsetAsync((char*)d_ws + WS_XBAR, 0, 16384, stream) != hipSuccess) { fprintf(stderr, "kernel_launch: hipMemsetAsync of the barrier words failed\n"); return; }
    a.ph_lo = 0; a.ph_hi = NPH;
    void* params[] = {&a};
    hipError_t e = hipLaunchCooperativeKernel((const void*)fwd_mega, dim3(grid), dim3(512), params, LDS_BYTES, stream);
    if (e != hipSuccess) fprintf(stderr, "kernel_launch: cooperative launch failed: %s (grid %d)\n", hipGetErrorString(e), grid);
#else
    for (int ph = 0; ph < NPH; ++ph) { a.ph_lo = ph; a.ph_hi = ph + 1; hipLaunchKernelGGL(fwd_mega, dim3(grid), dim3(512), LDS_BYTES, stream, a); }
#endif
}
```

```cpp
#include <hip/hip_runtime.h>
#include <hip/hip_cooperative_groups.h>
#include <cstdio>
#include <cstdint>
namespace cg = cooperative_groups;
namespace pg8 {
#define PG8_LAS __attribute__((address_space(3)))
typedef unsigned short bf16_t;
typedef short bf16x8 __attribute__((ext_vector_type(8)));
typedef float f32x4 __attribute__((ext_vector_type(4)));
typedef unsigned u32x4 __attribute__((ext_vector_type(4)));
constexpr int BM = 256, BK = 64, HALF = 128, HTB = HALF * BK * 2  , STAGE_BYTES = 8 * HTB, NXCD = 8, WGM = 8;

__host__ __device__ __forceinline__ int lds_byte(int r, int c) { const int st = (r >> 4) * 2 + (c >> 5), rr = r & 15, cc = c & 31, ob = rr * 64 + cc * 2; return st * 1024 + (ob ^ (((ob >> 9) & 1) << 5)); }
__host__ __device__ __forceinline__ void stage_rc(int b, int& R, int& C) { const int st = b / 1024, sb = b % 1024, swz = sb ^ (((sb >> 9) & 1) << 5); R = (st >> 1) * 16 + swz / 64; C = (st & 1) * 32 + (swz % 64) / 2; }
__host__ __device__ __forceinline__ int perm32(int rho) { const int n = rho >> 4, i = rho & 15; return 8 * (i >> 2) + 4 * n + (i & 3); }

struct Unit { int pm, pn; };
struct Gemm { const bf16_t* A; const bf16_t* Bt; int M, N, K; };

struct StaticOrder {
    int nM, nN, nwg, G, c;
    __host__ __device__ void init(int M, int N, int G_, int c_) { nM = M / BM; nN = N / BM; nwg = nM * nN; G = G_; c = c_; }
    __host__ __device__ bool next(int i, Unit& u) const {
        const long L = (long)i * G + c; if (L >= nwg) return false;
        int wgid = (int)L; { const int q = nwg / NXCD, r = nwg % NXCD, xcd = wgid % NXCD, off = wgid / NXCD; wgid = (xcd < r ? xcd * (q + 1) : r * (q + 1) + (xcd - r) * q) + off; }
        const int nig = WGM * nN, gid = wgid / nig, fm = gid * WGM, gsz = (nM - fm) < WGM ? (nM - fm) : WGM;
        u.pm = fm + ((wgid % nig) % gsz); u.pn = (wgid % nig) / gsz; return true;
    }
    __device__ __forceinline__ void a_ready(const Unit&) const {}
    __device__ __forceinline__ void done(const Unit&) const {}
};

template <class Epi, class Sched, bool ALIGN_EPI = false, bool SP2 = false>
__device__ __forceinline__ void gemm_phase(PG8_LAS unsigned char* lds, const Gemm g, const Sched& S, const Epi& E) {
    const int tid = threadIdx.x, wid = __builtin_amdgcn_readfirstlane(tid >> 6), lane = tid & 63, wr = wid >> 2, wc = wid & 3, fr = lane & 15, fq = lane >> 4;
    const int K = g.K, nt = K / BK;
    unsigned voffA[2], voffB[2];
#pragma unroll
    for (int i = 0; i < 2; ++i) { int R, C; stage_rc(tid * 16 + i * 8192, R, C); const int Rb = Epi::PERM ? ((R & ~31) + perm32(R & 31)) : R;
        voffA[i] = (unsigned)(R * K + C) * 2u; voffB[i] = (unsigned)(Rb * K + C) * 2u; }
    const size_t kstep = (size_t)(BK * 2);
    const size_t hstep = (size_t)HALF * K * 2;
    const size_t tstep = 2 * hstep;
    const unsigned ldsw = (unsigned)wid * 1024u;
    const int aoff = lds_byte(wr * 64 + fr, fq * 8), boff = lds_byte(wc * 32 + fr, fq * 8);
#define PG8_SA(b, h) (((b) * 2 + (h)) * HTB)
#define PG8_SB(b, h) ((4 + (b) * 2 + (h)) * HTB)
#define PG8_STAGE(bufoff, gbase, voff) do { _Pragma("unroll") for (int _i = 0; _i < 2; ++_i) \
        __builtin_amdgcn_global_load_lds((const unsigned*)((const char*)(gbase) + (voff)[_i]), (PG8_LAS unsigned*)(lds + (bufoff) + ldsw + _i * 8192), 16, 0, 0); } while (0)
#define PG8_LDA(dst, b, h) do { _Pragma("unroll") for (int m = 0; m < 4; ++m) _Pragma("unroll") for (int k = 0; k < 2; ++k) dst[m][k] = *(const PG8_LAS bf16x8*)(lds + PG8_SA(b, h) + aoff + m * 2048 + k * 1024); } while (0)
#define PG8_LDB(dst, b, h) do { _Pragma("unroll") for (int n = 0; n < 2; ++n) _Pragma("unroll") for (int k = 0; k < 2; ++k) dst[n][k] = *(const PG8_LAS bf16x8*)(lds + PG8_SB(b, h) + boff + n * 2048 + k * 1024); } while (0)
#define PG8_MMA(ai, bj, At, Bt) do { __builtin_amdgcn_s_setprio(1); _Pragma("unroll") for (int m = 0; m < 4; ++m) _Pragma("unroll") for (int n = 0; n < 2; ++n) _Pragma("unroll") for (int k = 0; k < 2; ++k) \
        acc[ai][bj][m][n] = __builtin_amdgcn_mfma_f32_16x16x32_bf16(Bt[n][k], At[m][k], acc[ai][bj][m][n], 0, 0, 0); __builtin_amdgcn_s_setprio(0); } while (0)
#define PG8_WAIT_V(n) asm volatile("s_waitcnt vmcnt(" #n ")" ::: "memory")
#define PG8_WAIT_L(n) asm volatile("s_waitcnt lgkmcnt(" #n ")" ::: "memory")
#define PG8_BAR __builtin_amdgcn_s_barrier()
#define PG8_SCHED __builtin_amdgcn_sched_barrier(0)
    Unit cur, nxt; int ui = 0;
    if (!S.next(0, cur)) return;
    f32x4 acc[2][2][4][2];
#pragma unroll
    for (int a = 0; a < 2; ++a)
#pragma unroll
        for (int b = 0; b < 2; ++b)
#pragma unroll
            for (int m = 0; m < 4; ++m)
#pragma unroll
                for (int n = 0; n < 2; ++n) acc[a][b][m][n] = (f32x4){0.f, 0.f, 0.f, 0.f};
    bf16x8 At[4][2], B0[2][2], B1[2][2];
    const char* cA = (const char*)g.A + (size_t)cur.pm * tstep; const char* cB = (const char*)g.Bt + (size_t)cur.pn * tstep;
    S.a_ready(cur);
    if constexpr (SP2) {
        PG8_STAGE(PG8_SB(0, 0), cB, voffB); PG8_STAGE(PG8_SB(0, 1), cB + hstep, voffB); PG8_STAGE(PG8_SA(0, 0), cA, voffA); PG8_STAGE(PG8_SA(0, 1), cA + hstep, voffA);
        if (wr == 1) PG8_BAR;
        PG8_WAIT_V(2); PG8_BAR;
        PG8_STAGE(PG8_SB(1, 0), cB + kstep, voffB); PG8_STAGE(PG8_SA(1, 0), cA + kstep, voffA); PG8_STAGE(PG8_SB(1, 1), cB + hstep + kstep, voffB);
        PG8_WAIT_V(6); PG8_BAR;
    } else {
        PG8_STAGE(PG8_SB(0, 0), cB, voffB); PG8_STAGE(PG8_SA(0, 0), cA, voffA); PG8_STAGE(PG8_SB(0, 1), cB + hstep, voffB); PG8_STAGE(PG8_SA(0, 1), cA + hstep, voffA);
        if (wr == 1) PG8_BAR;
        PG8_WAIT_V(4); PG8_BAR;
        PG8_STAGE(PG8_SB(1, 0), cB + kstep, voffB); PG8_STAGE(PG8_SA(1, 0), cA + kstep, voffA); PG8_STAGE(PG8_SB(1, 1), cB + hstep + kstep, voffB);
        PG8_WAIT_V(6); PG8_BAR;
    }
    for (;;) {
        const bool has_next = S.next(ui + 1, nxt);
        const char* nA = has_next ? (const char*)g.A + (size_t)nxt.pm * tstep : cA; const char* nB = has_next ? (const char*)g.Bt + (size_t)nxt.pn * tstep : cB;
        for (int t = 0; t < nt; t += 2) {
            const bool last = (t == nt - 2);
            const char* a1 = cA + (size_t)(t + 1) * kstep;
            const char* a2 = last ? nA : cA + (size_t)(t + 2) * kstep; const char* b2 = last ? nB : cB + (size_t)(t + 2) * kstep;
            const char* a3 = a2 + kstep; const char* b3 = b2 + kstep;
            if (last && has_next) S.a_ready(nxt);
            if constexpr (SP2) {
            PG8_LDB(B0, 0, 0); PG8_LDB(B1, 0, 1); PG8_SCHED; PG8_LDA(At, 0, 0); PG8_STAGE(PG8_SA(1, 1), a1 + hstep, voffA);
            PG8_WAIT_V(8); PG8_WAIT_L(0); PG8_BAR; PG8_MMA(0, 0, At, B0); PG8_MMA(0, 1, At, B1); PG8_BAR; PG8_SCHED;
            PG8_LDA(At, 0, 1); PG8_STAGE(PG8_SB(0, 0), b2, voffB); PG8_STAGE(PG8_SB(0, 1), b2 + hstep, voffB); PG8_STAGE(PG8_SA(0, 0), a2, voffA);
            PG8_WAIT_V(8); PG8_WAIT_L(0); PG8_BAR; PG8_MMA(1, 0, At, B0); PG8_MMA(1, 1, At, B1); PG8_BAR; PG8_SCHED;
            PG8_LDB(B0, 1, 0); PG8_LDB(B1, 1, 1); PG8_SCHED; PG8_LDA(At, 1, 0); PG8_STAGE(PG8_SA(0, 1), a2 + hstep, voffA);
            PG8_WAIT_V(8); PG8_WAIT_L(0); PG8_BAR; PG8_MMA(0, 0, At, B0); PG8_MMA(0, 1, At, B1); PG8_BAR; PG8_SCHED;
            PG8_LDA(At, 1, 1); PG8_STAGE(PG8_SB(1, 0), b3, voffB); PG8_STAGE(PG8_SB(1, 1), b3 + hstep, voffB); PG8_STAGE(PG8_SA(1, 0), a3, voffA);
            PG8_WAIT_V(8); PG8_WAIT_L(0); PG8_BAR; PG8_MMA(1, 0, At, B0); PG8_MMA(1, 1, At, B1); PG8_BAR; PG8_SCHED;
            } else {
            PG8_LDB(B0, 0, 0); PG8_SCHED; PG8_LDA(At, 0, 0); PG8_STAGE(PG8_SA(1, 1), a1 + hstep, voffA);
            PG8_WAIT_L(8); PG8_BAR; PG8_WAIT_L(0); PG8_MMA(0, 0, At, B0); PG8_BAR; PG8_SCHED;
            PG8_LDB(B1, 0, 1); PG8_STAGE(PG8_SB(0, 0), b2, voffB);
            PG8_BAR; PG8_WAIT_L(0); PG8_MMA(0, 1, At, B1); PG8_BAR;
            PG8_LDA(At, 0, 1); PG8_STAGE(PG8_SA(0, 0), a2, voffA);
            PG8_BAR; PG8_WAIT_L(0); PG8_MMA(1, 0, At, B0); PG8_BAR; PG8_SCHED;
            PG8_STAGE(PG8_SB(0, 1), b2 + hstep, voffB);
            PG8_WAIT_V(6); PG8_BAR; PG8_MMA(1, 1, At, B1); PG8_BAR;
            PG8_LDB(B0, 1, 0); PG8_SCHED; PG8_LDA(At, 1, 0); PG8_STAGE(PG8_SA(0, 1), a2 + hstep, voffA);
            PG8_WAIT_L(8); PG8_BAR; PG8_WAIT_L(0); PG8_MMA(0, 0, At, B0); PG8_BAR; PG8_SCHED;
            PG8_LDB(B1, 1, 1); PG8_STAGE(PG8_SB(1, 0), b3, voffB);
            PG8_BAR; PG8_WAIT_L(0); PG8_MMA(0, 1, At, B1); PG8_BAR;
            PG8_LDA(At, 1, 1); PG8_STAGE(PG8_SA(1, 0), a3, voffA);
            PG8_BAR; PG8_WAIT_L(0); PG8_MMA(1, 0, At, B0); PG8_BAR; PG8_SCHED;
            PG8_STAGE(PG8_SB(1, 1), b3 + hstep, voffB);
            PG8_WAIT_V(6); PG8_BAR; PG8_MMA(1, 1, At, B1); PG8_BAR;
            }
        }
        if constexpr (ALIGN_EPI) { if (wr == 0) PG8_BAR; }
        if constexpr (!Epi::AFTER_DRAIN) { E(acc, cur, wr, wc, fr, fq); S.done(cur); }
        if (!has_next) break;
#pragma unroll
        for (int a = 0; a < 2; ++a)
#pragma unroll
            for (int b = 0; b < 2; ++b)
#pragma unroll
                for (int m = 0; m < 4; ++m)
#pragma unroll
                    for (int n = 0; n < 2; ++n) acc[a][b][m][n] = (f32x4){0.f, 0.f, 0.f, 0.f};
        cur = nxt; cA = nA; cB = nB; ++ui;
        if constexpr (ALIGN_EPI) { if (wr == 1) PG8_BAR; }
    }
    PG8_WAIT_V(0);
    if constexpr (!ALIGN_EPI) { if (wr == 0) PG8_BAR; }
    PG8_BAR;
    if constexpr (Epi::AFTER_DRAIN) { E.fused(acc, cur, wr, wc, fr, fq, lds, wid, lane); S.done(cur); }
#undef PG8_SA
#undef PG8_SB
#undef PG8_STAGE
#undef PG8_LDA
#undef PG8_LDB
#undef PG8_MMA
#undef PG8_WAIT_V
#undef PG8_WAIT_L
#undef PG8_BAR
#undef PG8_SCHED
}
}

#define LAS __attribute__((address_space(3)))
constexpr int NB = 32, SEQ = 2048, DM = 1024, MT = NB * SEQ;
constexpr int NH = 8, HD = 64, SBW = 512, RWW = 512, RWC = 1792, GC = 2048, INC = 5376, FF = 4096, PLE = 256;
constexpr int NMAIN = 4864;
constexpr int NPH = 11;
#ifndef PROBE_PHASE
#define PROBE_PHASE -1
#endif
#ifndef MK_ONE_LAUNCH
#define MK_ONE_LAUNCH 1
#endif
constexpr size_t MiB = 1u << 20;
constexpr size_t WS_WIN = 2 * MiB, WS_WSB = 13 * MiB, WS_WRW = 14 * MiB, WS_WOUT = 15 * MiB, WS_W1 = 17 * MiB, WS_W2 = 25 * MiB, WS_WG = 33 * MiB, WS_WP = 35 * MiB,
                 WS_LW2 = 36 * MiB, WS_LA2 = 36 * MiB + 65536, WS_LG2 = 36 * MiB + 131072;
constexpr size_t WS_PB = 40 * MiB, WS_H = 72 * MiB, WS_Q = 200 * MiB, WS_K = 264 * MiB, WS_VT = 328 * MiB, WS_U = 392 * MiB, WS_G = 616 * MiB, WS_OSB = 872 * MiB, WS_ORW = 936 * MiB, WS_END = 1000 * MiB;
constexpr size_t WS_F = 200 * MiB, WS_TMP = 712 * MiB;
constexpr int LDS_BYTES = 147456;
constexpr size_t WS_XBAR = 900 * 1024;

typedef unsigned short bf16_t;
typedef float f32x2 __attribute__((ext_vector_type(2)));
typedef float f32x4 __attribute__((ext_vector_type(4)));
typedef float f32x16 __attribute__((ext_vector_type(16)));
typedef unsigned u32x2 __attribute__((ext_vector_type(2)));
typedef unsigned u32x4 __attribute__((ext_vector_type(4)));
typedef short bf16x8 __attribute__((ext_vector_type(8)));
typedef __bf16 bf16x2_t __attribute__((ext_vector_type(2)));

__device__ __forceinline__ unsigned pkbf(float lo, float hi) { f32x2 v = {lo, hi}; bf16x2_t b = __builtin_convertvector(v, bf16x2_t); return __builtin_bit_cast(unsigned, b); }
__device__ __forceinline__ float bflo(unsigned w) { return __uint_as_float(w << 16); }
__device__ __forceinline__ float bfhi(unsigned w) { return __uint_as_float(w & 0xffff0000u); }
__device__ __forceinline__ float flog1p_(float e) { return __builtin_amdgcn_logf(1.f + e) * 0.69314718f; }
__device__ __forceinline__ float sigm(float x) { return __builtin_amdgcn_rcpf(1.f + __expf(-x)); }
__device__ __forceinline__ float wave_sum(float v) {
#pragma unroll
    for (int o = 1; o < 64; o <<= 1) v += __shfl_xor(v, o);
    return v;
}
template <int CTRL> __device__ __forceinline__ float dppf(float v) { return __int_as_float(__builtin_amdgcn_update_dpp(0, __float_as_int(v), CTRL, 0xF, 0xF, true)); }
__device__ __forceinline__ float red8(float v) { v += dppf<0xB1>(v); v += dppf<0x4E>(v); v += dppf<0x141>(v); return v; }
__device__ __forceinline__ float red16(float v) { v = red8(v); v += dppf<0x140>(v); return v; }

struct NoPre {};
template <class F> struct EpiGen {
    static constexpr bool PERM = true, AFTER_DRAIN = false; F f;
    __device__ __forceinline__ void operator()(const pg8::f32x4 (&acc)[2][2][4][2], const pg8::Unit& u, int wr, int wc, int fr, int fq) const {
        const int row0 = u.pm * 256 + wr * 64 + fr, col0 = u.pn * 256 + wc * 32 + 8 * fq;
        if constexpr (F::NB == 1) {
            typename F::Pre p[2][4][2];
#pragma unroll
            for (int ai = 0; ai < 2; ++ai)
#pragma unroll
                for (int m = 0; m < 4; ++m)
#pragma unroll
                    for (int bj = 0; bj < 2; ++bj) f.pre(row0 + ai * 128 + m * 16, col0 + bj * 128, p[ai][m][bj]);
#pragma unroll
            for (int ai = 0; ai < 2; ++ai)
#pragma unroll
                for (int m = 0; m < 4; ++m)
#pragma unroll
                    for (int bj = 0; bj < 2; ++bj) f(row0 + ai * 128 + m * 16, col0 + bj * 128, acc[ai][bj][m][0], acc[ai][bj][m][1], p[ai][m][bj]);
        } else if constexpr (F::NB == 2) {
#pragma unroll
            for (int ai = 0; ai < 2; ++ai) {
                typename F::Pre p[4][2];
#pragma unroll
                for (int m = 0; m < 4; ++m)
#pragma unroll
                    for (int bj = 0; bj < 2; ++bj) f.pre(row0 + ai * 128 + m * 16, col0 + bj * 128, p[m][bj]);
#pragma unroll
                for (int m = 0; m < 4; ++m)
#pragma unroll
                    for (int bj = 0; bj < 2; ++bj) f(row0 + ai * 128 + m * 16, col0 + bj * 128, acc[ai][bj][m][0], acc[ai][bj][m][1], p[m][bj]);
            }
        } else {
#pragma unroll
            for (int ai = 0; ai < 2; ++ai)
#pragma unroll
                for (int mp = 0; mp < 2; ++mp) {
                    typename F::Pre p[2][2];
#pragma unroll
                    for (int mm = 0; mm < 2; ++mm)
#pragma unroll
                        for (int bj = 0; bj < 2; ++bj) f.pre(row0 + ai * 128 + (2 * mp + mm) * 16, col0 + bj * 128, p[mm][bj]);
#pragma unroll
                    for (int mm = 0; mm < 2; ++mm)
#pragma unroll
                        for (int bj = 0; bj < 2; ++bj) f(row0 + ai * 128 + (2 * mp + mm) * 16, col0 + bj * 128, acc[ai][bj][2 * mp + mm][0], acc[ai][bj][2 * mp + mm][1], p[mm][bj]);
                }
        }
    }
};
__device__ __forceinline__ u32x4 pack8(f32x4 a, f32x4 b) { u32x4 w; w.x = pkbf(a[0], a[1]); w.y = pkbf(a[2], a[3]); w.z = pkbf(b[0], b[1]); w.w = pkbf(b[2], b[3]); return w; }
__device__ __forceinline__ void unpack8(u32x4 w, f32x4& a, f32x4& b) { a = (f32x4){bflo(w.x), bfhi(w.x), bflo(w.y), bfhi(w.y)}; b = (f32x4){bflo(w.z), bfhi(w.z), bflo(w.w), bfhi(w.w)}; }
__device__ __forceinline__ f32x4 sigm4(f32x4 v) { return (f32x4){sigm(v[0]), sigm(v[1]), sigm(v[2]), sigm(v[3])}; }

struct FInproj {
    bf16_t *Q, *K, *U, *G; typedef NoPre Pre; static constexpr int NB = 1;
    __device__ __forceinline__ void pre(int, int, Pre&) const {}
    __device__ __forceinline__ void operator()(int row, int col, f32x4 v0, f32x4 v1, const Pre&) const {
        const int pn = col >> 8; bf16_t* p;
        if (pn < 2) { p = Q + (size_t)row * 512 + col; v0 = v0 * 0.125f; v1 = v1 * 0.125f; }
        else if (pn < 4) { p = K + (size_t)row * 512 + (col - 512); }
        else if (pn < 11) { p = U + (size_t)row * RWC + (col - 1024); }
        else { p = G + (size_t)row * GC + (col - 2816); }
        __builtin_nontemporal_store(pack8(v0, v1), (u32x4*)p);
    }
};
struct FStore {
    bf16_t* O; int ld; typedef NoPre Pre; static constexpr int NB = 1;
    __device__ __forceinline__ void pre(int, int, Pre&) const {}
    __device__ __forceinline__ void operator()(int row, int col, f32x4 v0, f32x4 v1, const Pre&) const { *(u32x4*)(O + (size_t)row * ld + col) = pack8(v0, v1); }
};
struct FMergeA {
    const bf16_t* G; bf16_t* MG; struct Pre { u32x4 g; }; static constexpr int NB = 2;
    __device__ __forceinline__ void pre(int row, int col, Pre& p) const { p.g = *(const u32x4*)(G + (size_t)row * GC + col); }
    __device__ __forceinline__ void operator()(int row, int col, f32x4 v0, f32x4 v1, const Pre& p) const {
        f32x4 g0, g1; unpack8(p.g, g0, g1); g0 = sigm4(g0); g1 = sigm4(g1);
        *(u32x4*)(MG + (size_t)row * DM + col) = pack8(g0 * v0, g1 * v1);
    }
};
struct FMergeB {
    const bf16_t* G; bf16_t* MG; struct Pre { u32x4 g, m; }; static constexpr int NB = 2;
    __device__ __forceinline__ void pre(int row, int col, Pre& p) const { p.g = *(const u32x4*)(G + (size_t)row * GC + 1024 + col); p.m = *(const u32x4*)(MG + (size_t)row * DM + col); }
    __device__ __forceinline__ void operator()(int row, int col, f32x4 v0, f32x4 v1, const Pre& p) const {
        f32x4 g0, g1, m0, m1; unpack8(p.g, g0, g1); g0 = sigm4(g0); g1 = sigm4(g1);
        unpack8(p.m, m0, m1);
        *(u32x4*)(MG + (size_t)row * DM + col) = pack8(m0 + g0 * v0, m1 + g1 * v1);
    }
};
__device__ __forceinline__ void row_ss_add(float* SS, int row, f32x4 o0, f32x4 o1) {
    float s = ((o0[0] * o0[0] + o0[1] * o0[1]) + (o0[2] * o0[2] + o0[3] * o0[3])) + ((o1[0] * o1[0] + o1[1] * o1[1]) + (o1[2] * o1[2] + o1[3] * o1[3]));
    s += __shfl_xor(s, 16); s += __shfl_xor(s, 32);
    if ((threadIdx.x & 48) == 0) atomicAdd(SS + row, s);
}
struct FRes4 {
    const float* base; bf16_t* XB; float* SS; struct Pre { f32x4 b0, b1; }; static constexpr int NB = 2;
    __device__ __forceinline__ void pre(int row, int col, Pre& p) const { const size_t o = (size_t)row * DM + col; p.b0 = *(const f32x4*)(base + o); p.b1 = *(const f32x4*)(base + o + 4); }
    __device__ __forceinline__ void operator()(int row, int col, f32x4 v0, f32x4 v1, const Pre& p) const {
        const size_t o = (size_t)row * DM + col; const f32x4 o0 = p.b0 + v0, o1 = p.b1 + v1;
        *(u32x4*)(XB + o) = pack8(o0, o1);
        row_ss_add(SS, row, o0, o1);
    }
};
struct FRes7 {
    const bf16_t* base; bf16_t* XB; float* SS; struct Pre { u32x4 b; }; static constexpr int NB = 2;
    __device__ __forceinline__ void pre(int row, int col, Pre& p) const { p.b = *(const u32x4*)(base + (size_t)row * DM + col); }
    __device__ __forceinline__ void operator()(int row, int col, f32x4 v0, f32x4 v1, const Pre& p) const {
        const size_t o = (size_t)row * DM + col; f32x4 b0, b1; unpack8(p.b, b0, b1); const f32x4 o0 = b0 + v0, o1 = b1 + v1;
        *(u32x4*)(XB + o) = pack8(o0, o1);
        row_ss_add(SS, row, o0, o1);
    }
};
struct FRelu2 {
    bf16_t* F; const float* SS; struct Pre { float ss; }; static constexpr int NB = 1;
    __device__ __forceinline__ void pre(int row, int, Pre& p) const { p.ss = SS[row]; }
    __device__ __forceinline__ void operator()(int row, int col, f32x4 v0, f32x4 v1, const Pre& p) const {
        const float rs = rsqrtf(p.ss * (1.f / DM) + 1e-6f);
        f32x4 z = {0.f, 0.f, 0.f, 0.f}; v0 = __builtin_elementwise_max(v0 * rs, z); v1 = __builtin_elementwise_max(v1 * rs, z);
        __builtin_nontemporal_store(pack8(v0 * v0, v1 * v1), (u32x4*)(F + (size_t)row * FF + col));
    }
};
struct FPle {
    const bf16_t* T; float* X; const float* SS; float* SS3; typedef NoPre Pre; static constexpr int NB = 1;
    __device__ __forceinline__ void pre(int, int, Pre&) const {}
    __device__ __forceinline__ void operator()(int row, int col, f32x4 v0, f32x4 v1, const Pre&) const {
        const float rs = rsqrtf(SS[row] * (1.f / DM) + 1e-6f);
        const size_t o = (size_t)row * DM + col; f32x4 t0, t1; unpack8(*(const u32x4*)(T + o), t0, t1);
        const f32x4 b0 = *(const f32x4*)(X + o), b1 = *(const f32x4*)(X + o + 4);
        const f32x4 o0 = b0 + sigm4(v0 * rs) * t0, o1 = b1 + sigm4(v1 * rs) * t1;
        *(f32x4*)(X + o) = o0; *(f32x4*)(X + o + 4) = o1;
        row_ss_add(SS3, row, o0, o1);
    }
};

struct EpiPleFinal {
    static constexpr bool PERM = true, AFTER_DRAIN = false;
    const bf16_t* T; const bf16_t* XB; float* X; const float* SS2; float* SS3; unsigned* CNT; const float* gfin;
    __device__ __forceinline__ void operator()(pg8::f32x4 (&acc)[2][2][4][2], const pg8::Unit& u, int wr, int wc, int fr, int fq) const {
        const int row0 = u.pm * 256 + wr * 64 + fr, col0 = u.pn * 256 + wc * 32 + 8 * fq;
        float rsum[2][4];
#pragma unroll
        for (int ai = 0; ai < 2; ++ai)
#pragma unroll
            for (int mp = 0; mp < 2; ++mp) {
                u32x4 tq[2][2], xq[2][2]; float s2[2];
#pragma unroll
                for (int mm = 0; mm < 2; ++mm) { const int row = row0 + ai * 128 + (2 * mp + mm) * 16; s2[mm] = SS2[row];
#pragma unroll
                    for (int bj = 0; bj < 2; ++bj) { const size_t o = (size_t)row * DM + col0 + bj * 128; tq[mm][bj] = *(const u32x4*)(T + o); xq[mm][bj] = *(const u32x4*)(XB + o); } }
#pragma unroll
                for (int mm = 0; mm < 2; ++mm) { const int m = 2 * mp + mm, row = row0 + ai * 128 + m * 16; const float rs = rsqrtf(s2[mm] * (1.f / DM) + 1e-6f); float ssum = 0.f;
#pragma unroll
                    for (int bj = 0; bj < 2; ++bj) {
                        f32x4 t0, t1, x0, x1; unpack8(tq[mm][bj], t0, t1); unpack8(xq[mm][bj], x0, x1);
                        const f32x4 o0 = x0 + sigm4(acc[ai][bj][m][0] * rs) * t0, o1 = x1 + sigm4(acc[ai][bj][m][1] * rs) * t1;
                        acc[ai][bj][m][0] = o0; acc[ai][bj][m][1] = o1;
                        ssum += ((o0[0] * o0[0] + o0[1] * o0[1]) + (o0[2] * o0[2] + o0[3] * o0[3])) + ((o1[0] * o1[0] + o1[1] * o1[1]) + (o1[2] * o1[2] + o1[3] * o1[3]));
                    }
                    ssum += __shfl_xor(ssum, 16); ssum += __shfl_xor(ssum, 32);
                    rsum[ai][m] = ssum; }
            }
        if (fq == 0) {
#pragma unroll
            for (int ai = 0; ai < 2; ++ai)
#pragma unroll
                for (int m = 0; m < 4; ++m) atomicAdd(SS3 + row0 + ai * 128 + m * 16, rsum[ai][m]);
        }
        asm volatile("s_waitcnt vmcnt(0)" ::: "memory");
        unsigned* cw = CNT + 64 * u.pm;
        if ((threadIdx.x & 63) == 0) __hip_atomic_fetch_add(cw, 1u, __ATOMIC_RELAXED, __HIP_MEMORY_SCOPE_AGENT);
        for (int spin = 0; spin < (1 << 22); ++spin) {
            if (__hip_atomic_load(cw, __ATOMIC_RELAXED, __HIP_MEMORY_SCOPE_AGENT) >= 32u) break;
            __builtin_amdgcn_s_sleep(2);
        }
        f32x4 gv[2][2];
#pragma unroll
        for (int bj = 0; bj < 2; ++bj) { gv[bj][0] = *(const f32x4*)(gfin + col0 + bj * 128); gv[bj][1] = *(const f32x4*)(gfin + col0 + bj * 128 + 4); }
        float ss3[2][4];
#pragma unroll
        for (int ai = 0; ai < 2; ++ai)
#pragma unroll
            for (int m = 0; m < 4; ++m) ss3[ai][m] = __hip_atomic_load(SS3 + row0 + ai * 128 + m * 16, __ATOMIC_RELAXED, __HIP_MEMORY_SCOPE_AGENT);
#pragma unroll
        for (int ai = 0; ai < 2; ++ai)
#pragma unroll
            for (int m = 0; m < 4; ++m) {
                const int row = row0 + ai * 128 + m * 16;
                const float rs = rsqrtf(ss3[ai][m] * (1.f / DM) + 1e-6f);
#pragma unroll
                for (int bj = 0; bj < 2; ++bj) { const size_t o = (size_t)row * DM + col0 + bj * 128;
                    *(f32x4*)(X + o) = acc[ai][bj][m][0] * rs * gv[bj][0]; *(f32x4*)(X + o + 4) = acc[ai][bj][m][1] * rs * gv[bj][1]; }
            }
    }
};

template <bool ALIGN = true, class F> __device__ __forceinline__ void run_gemm(LAS unsigned char* lds, const bf16_t* A, const bf16_t* Bt, int M, int N, int K, const F& f) {
    pg8::Gemm g{A, Bt, M, N, K}; pg8::StaticOrder S; S.init(M, N, (int)gridDim.x, (int)blockIdx.x);
    EpiGen<F> E{f};
    pg8::gemm_phase<EpiGen<F>, pg8::StaticOrder, ALIGN, true>(lds, g, S, E);
}

__device__ __forceinline__ void transpose_item(const float* W, int K, int N, bf16_t* WT, int k0, int n0, int dst_row0, LAS float* scr, int lane, const float* gk = nullptr) {
#pragma unroll 8
    for (int i = 0; i < 32; ++i) { const int kk = 2 * i + (lane >> 5); float wv = W[(size_t)(k0 + kk) * N + n0 + (lane & 31)]; if (gk) wv *= gk[k0 + kk]; scr[kk * 33 + (lane & 31)] = wv; }
    asm volatile("s_waitcnt lgkmcnt(0)" ::: "memory");
    const int c = lane & 7;
#pragma unroll
    for (int j = 0; j < 4; ++j) { const int n = (lane >> 3) + 8 * j; const LAS float* s = scr + (8 * c) * 33 + n;
        u32x4 o; o.x = pkbf(s[0 * 33], s[1 * 33]); o.y = pkbf(s[2 * 33], s[3 * 33]); o.z = pkbf(s[4 * 33], s[5 * 33]); o.w = pkbf(s[6 * 33], s[7 * 33]);
        *(u32x4*)(WT + (size_t)(dst_row0 + n) * K + k0 + 8 * c) = o; }
    asm volatile("s_waitcnt lgkmcnt(0)" ::: "memory");
}
__device__ __forceinline__ int win_dst(int n0) { return n0 < 1024 ? n0 : (n0 < 1536 ? n0 - 1024 + NMAIN : (n0 < 3328 ? n0 - 1536 + 1024 : n0 - 3328 + 2816)); }

__device__ __forceinline__ void rms_row_bf16(const float* xrow, const float* g, bf16_t* orow, int lane) {
    const f32x4* xr = (const f32x4*)xrow + lane; const f32x4* gr = (const f32x4*)g + lane;
    f32x4 v[4]; float s = 0.f;
#pragma unroll
    for (int j = 0; j < 4; ++j) { v[j] = xr[64 * j]; s += (v[j].x * v[j].x + v[j].y * v[j].y) + (v[j].z * v[j].z + v[j].w * v[j].w); }
    const float rstd = rsqrtf(wave_sum(s) * (1.f / DM) + 1e-6f);
    u32x2* o8 = (u32x2*)orow + lane;
#pragma unroll
    for (int j = 0; j < 4; ++j) { const f32x4 gg = gr[64 * j]; const f32x4 y = v[j] * rstd * gg; u32x2 w; w.x = pkbf(y.x, y.y); w.y = pkbf(y.z, y.w); o8[64 * j] = w; }
}
__device__ __forceinline__ void rms_row_f32(float* xrow, const float* g, int lane, float ss) {
    f32x4* xr = (f32x4*)xrow + lane; const f32x4* gr = (const f32x4*)g + lane;
    f32x4 v[4];
#pragma unroll
    for (int j = 0; j < 4; ++j) v[j] = xr[64 * j];
    const float rstd = rsqrtf(ss * (1.f / DM) + 1e-6f);
#pragma unroll
    for (int j = 0; j < 4; ++j) xr[64 * j] = v[j] * rstd * gr[64 * j];
}

__device__ __forceinline__ void sb_attn_unit(const bf16_t* __restrict__ Q, const bf16_t* __restrict__ K, const bf16_t* __restrict__ Vt, bf16_t* __restrict__ O, int bh, int qt, int lane) {
    const int b = bh >> 3, h = bh & 7, n = lane & 31, hi = lane >> 5;
    const size_t tok0 = (size_t)b * SEQ; const int q0 = qt * 32;
    bf16x8 qf[4];
#pragma unroll
    for (int d0 = 0; d0 < 4; ++d0) qf[d0] = *(const bf16x8*)(Q + (tok0 + q0 + n) * SBW + h * HD + d0 * 16 + hi * 8);
    f32x16 o0, o1;
#pragma unroll
    for (int r = 0; r < 16; ++r) { o0[r] = 0.f; o1[r] = 0.f; }
    float C = 0.f;
    const int mk = (n & ~12) | ((n & 4) << 1) | ((n & 8) >> 1);
    const bf16_t* vbase = Vt + (size_t)(h * HD + n) * MT + tok0 + 8 * hi;
    bf16x8 kn[4], vn[2][2];
    {
        const bf16_t* kp = K + (tok0 + qt * 32 + mk) * SBW + h * HD + hi * 8;
#pragma unroll
        for (int d0 = 0; d0 < 4; ++d0) kn[d0] = *(const bf16x8*)(kp + d0 * 16);
#pragma unroll
        for (int dh = 0; dh < 2; ++dh)
#pragma unroll
            for (int kk = 0; kk < 2; ++kk) vn[dh][kk] = *(const bf16x8*)(vbase + (size_t)dh * 32 * MT + qt * 32 + 16 * kk);
    }
    for (int kt = qt; kt >= 0; --kt) {
        const int k0 = kt * 32;
        bf16x8 kf[4], vf[2][2];
#pragma unroll
        for (int d0 = 0; d0 < 4; ++d0) kf[d0] = kn[d0];
#pragma unroll
        for (int dh = 0; dh < 2; ++dh)
#pragma unroll
            for (int kk = 0; kk < 2; ++kk) vf[dh][kk] = vn[dh][kk];
        if (kt > 0) {
            const bf16_t* kp = K + (tok0 + k0 - 32 + mk) * SBW + h * HD + hi * 8;
#pragma unroll
            for (int d0 = 0; d0 < 4; ++d0) kn[d0] = *(const bf16x8*)(kp + d0 * 16);
#pragma unroll
            for (int dh = 0; dh < 2; ++dh)
#pragma unroll
                for (int kk = 0; kk < 2; ++kk) vn[dh][kk] = *(const bf16x8*)(vbase + (size_t)dh * 32 * MT + k0 - 32 + 16 * kk);
        }
        f32x16 z;
#pragma unroll
        for (int r = 0; r < 16; ++r) z[r] = 0.f;
#pragma unroll
        for (int d0 = 0; d0 < 4; ++d0) z = __builtin_amdgcn_mfma_f32_32x32x16_bf16(kf[d0], qf[d0], z, 0, 0, 0);
        float L[16]; const int qpos = q0 + n; const bool diag = (kt == qt);
#pragma unroll
        for (int r = 0; r < 16; ++r) {
            const float zz = z[r]; const float e = __expf(-fabsf(zz));
            float l = fminf(-zz, 0.f) - flog1p_(e);
            if (diag) { const int key = k0 + (r & 7) + 8 * hi + 16 * (r >> 3); if (key >= qpos) l = 0.f; }
            L[r] = l;
        }
#pragma unroll
        for (int r = 6; r >= 0; --r) { L[r] += L[r + 1]; L[r + 8] += L[r + 9]; }
        const float sA = L[0], sB = L[8];
        const float pA = __shfl_xor(sA, 32), pB = __shfl_xor(sB, 32);
        const float offA = (hi ? (pB + sB) : (pA + sB + pB)) + C, offB = (hi ? 0.f : pB) + C;
        float w[16];
#pragma unroll
        for (int r = 0; r < 16; ++r) {
            float lw = z[r] + L[r] + (r < 8 ? offA : offB); float e = __expf(lw);
            if (diag) { const int key = k0 + (r & 7) + 8 * hi + 16 * (r >> 3); if (key >= qpos) e = 0.f; }
            w[r] = e;
        }
        C += (sA + sB) + (pA + pB);
        u32x4 w0, w1; w0.x = pkbf(w[0], w[1]); w0.y = pkbf(w[2], w[3]); w0.z = pkbf(w[4], w[5]); w0.w = pkbf(w[6], w[7]);
        w1.x = pkbf(w[8], w[9]); w1.y = pkbf(w[10], w[11]); w1.z = pkbf(w[12], w[13]); w1.w = pkbf(w[14], w[15]);
        const bf16x8 wb0 = __builtin_bit_cast(bf16x8, w0), wb1 = __builtin_bit_cast(bf16x8, w1);
        o0 = __builtin_amdgcn_mfma_f32_32x32x16_bf16(vf[0][0], wb0, o0, 0, 0, 0);
        o0 = __builtin_amdgcn_mfma_f32_32x32x16_bf16(vf[0][1], wb1, o0, 0, 0, 0);
        o1 = __builtin_amdgcn_mfma_f32_32x32x16_bf16(vf[1][0], wb0, o1, 0, 0, 0);
        o1 = __builtin_amdgcn_mfma_f32_32x32x16_bf16(vf[1][1], wb1, o1, 0, 0, 0);
        if (__all(C < -40.f)) break;
    }
    bf16_t* op = O + (tok0 + q0 + n) * SBW + h * HD + 4 * hi;
#pragma unroll
    for (int i = 0; i < 4; ++i) {
        u32x2 a; a.x = pkbf(o0[4 * i], o0[4 * i + 1]); a.y = pkbf(o0[4 * i + 2], o0[4 * i + 3]); *(u32x2*)(op + 8 * i) = a;
        u32x2 c; c.x = pkbf(o1[4 * i], o1[4 * i + 1]); c.y = pkbf(o1[4 * i + 2], o1[4 * i + 3]); *(u32x2*)(op + 32 + 8 * i) = c;
    }
}

constexpr int RW_T = 32;
constexpr int RS1 = 144, RS2 = 272, RS3 = 80;
constexpr int O_WF = 0, O_Y = 0, O_GAM = 8192, O_AT = 16384, O_RT = 20992, O_BT = 25600, O_KT = 30208, O_BTT = 34816, O_KTT = 39936, O_VT = 45056, O_WT = 50176, O_UT = 55296,
              O_LABF = 60416, O_LAK = 64512, O_LRB = 67072, O_LRK = 69632, O_INV = 72192, O_SIMG = 74752, O_GG = 83968, O_W2 = 92160, O_A2 = 101376, O_G2 = 110592, O_CONST = 128000, O_RW_END = 128000 + 4096;
constexpr int O_XW = O_AT, O_XA = O_RT, O_XG = O_BT;
constexpr int O_PW = O_BTT, O_PA = O_BTT + 8192;
static_assert(O_RW_END <= LDS_BYTES && O_XG + 32 * RS2 <= O_BTT && O_PA + 8192 <= O_LABF, "rwkv LDS map");
struct RwParams { const bf16_t* U; const bf16_t* XA; const bf16_t *w2T, *a2T, *g2T; const float *mu, *w0, *a0, *k_k, *k_a, *r_k, *ln_w, *ln_b; bf16_t* O; };

template <int NK> __device__ __forceinline__ f32x16 mm_tile(f32x16 acc, const LAS unsigned char* A, int as, const LAS unsigned char* B, int bs, int lane) {
    const int n = lane & 31, hi = lane >> 5;
#pragma unroll
    for (int kk = 0; kk < NK; ++kk) {
        const bf16x8 af = *(const LAS bf16x8*)(A + n * as + (16 * kk + 8 * hi) * 2);
        const bf16x8 bf = *(const LAS bf16x8*)(B + n * bs + (16 * kk + 8 * hi) * 2);
        acc = __builtin_amdgcn_mfma_f32_32x32x16_bf16(af, bf, acc, 0, 0, 0);
    }
    return acc;
}
__device__ __forceinline__ void store_T_img(const f32x16& acc, LAS unsigned char* img, int col, int hi) {
#pragma unroll
    for (int i = 0; i < 4; ++i) { u32x2 w; w.x = pkbf(acc[4 * i], acc[4 * i + 1]); w.y = pkbf(acc[4 * i + 2], acc[4 * i + 3]); *(LAS u32x2*)(img + col * RS3 + (8 * i + 4 * hi) * 2) = w; }
}
__device__ __forceinline__ f32x16 zero16() { f32x16 z;
#pragma unroll
    for (int r = 0; r < 16; ++r) z[r] = 0.f;
    return z; }

__device__ __forceinline__ void rwkv_unit(const RwParams& P, int bh, LAS unsigned char* lds) {
    const int tid = threadIdx.x, lane = tid & 63, wv = __builtin_amdgcn_readfirstlane(tid >> 6);
    const int b = bh >> 3, h = bh & 7;
    const int tok = tid >> 4, j = tid & 15, c4 = 4 * j;
    const int ln = lane & 31, lhi = lane >> 5;
    LAS float* CST = (LAS float*)(lds + O_CONST);
    __syncthreads();
    {
        const int row = tid >> 3, ch = tid & 7;
        *(LAS u32x4*)(lds + O_W2 + row * RS1 + ch * 16) = *(const u32x4*)(P.w2T + (size_t)(h * HD + row) * 64 + ch * 8);
        *(LAS u32x4*)(lds + O_A2 + row * RS1 + ch * 16) = *(const u32x4*)(P.a2T + (size_t)(h * HD + row) * 64 + ch * 8);
#pragma unroll
        for (int i = 0; i < 2; ++i) { const int id = tid + 512 * i, r2 = id >> 4, c2 = id & 15;
            *(LAS u32x4*)(lds + O_G2 + r2 * RS2 + c2 * 16) = *(const u32x4*)(P.g2T + (size_t)(h * HD + r2) * 128 + c2 * 8); }
        if (tid < 64) { CST[tid] = P.mu[h * HD + tid]; CST[64 + tid] = P.mu[512 + h * HD + tid]; CST[128 + tid] = P.mu[1024 + h * HD + tid];
            CST[448 + tid] = P.w0[h * HD + tid]; CST[512 + tid] = P.a0[h * HD + tid]; CST[576 + tid] = P.k_k[h * HD + tid]; CST[640 + tid] = P.k_a[h * HD + tid];
            CST[704 + tid] = P.r_k[h * HD + tid]; CST[768 + tid] = P.ln_w[h * HD + tid]; CST[832 + tid] = P.ln_b[h * HD + tid]; }
        if (tid < 256) CST[192 + tid] = P.mu[1536 + tid];
        for (int i = tid; i < 9216 / 16; i += 512) *(LAS u32x4*)(lds + O_SIMG + i * 16) = (u32x4){0u, 0u, 0u, 0u};
    }
    __syncthreads();
    f32x16 St = zero16();
    const bf16_t* Ub = P.U + (size_t)b * SEQ * RWC;
    bf16_t* Ob = P.O + (size_t)b * SEQ * RWW + h * HD + c4;

    u32x2 cr, ck, cv, pr, pk, pv; u32x4 cx0, cx1;
    const bf16_t* Xb = P.XA + (size_t)b * SEQ * 256 + 16 * j;
#define RW_LOAD(c) do { const int t_ = (c) * RW_T + tok; const bf16_t* rp = Ub + (size_t)t_ * RWC; \
        cr = *(const u32x2*)(rp + h * HD + c4); ck = *(const u32x2*)(rp + 512 + h * HD + c4); cv = *(const u32x2*)(rp + 1024 + h * HD + c4); \
        cx0 = *(const u32x4*)(Xb + (size_t)t_ * 256); cx1 = *(const u32x4*)(Xb + (size_t)t_ * 256 + 8); \
        if (t_ > 0) { const bf16_t* qp = rp - RWC; pr = *(const u32x2*)(qp + h * HD + c4); pk = *(const u32x2*)(qp + 512 + h * HD + c4); pv = *(const u32x2*)(qp + 1024 + h * HD + c4); } \
        else { pr = (u32x2){0u, 0u}; pk = pr; pv = pr; } } while (0)
    RW_LOAD(0);
    u32x2 wout = {0u, 0u};
    for (int c = 0; c < SEQ / RW_T; ++c) {
        float rr[4], kx[4], vx[4];
        {
            const float cr_[4] = {bflo(cr.x), bfhi(cr.x), bflo(cr.y), bfhi(cr.y)}, pr_[4] = {bflo(pr.x), bfhi(pr.x), bflo(pr.y), bfhi(pr.y)};
            const float ck_[4] = {bflo(ck.x), bfhi(ck.x), bflo(ck.y), bfhi(ck.y)}, pk_[4] = {bflo(pk.x), bfhi(pk.x), bflo(pk.y), bfhi(pk.y)};
            const float cv_[4] = {bflo(cv.x), bfhi(cv.x), bflo(cv.y), bfhi(cv.y)}, pv_[4] = {bflo(pv.x), bfhi(pv.x), bflo(pv.y), bfhi(pv.y)};
            const f32x4 mr = *(const LAS f32x4*)(CST + c4), mk = *(const LAS f32x4*)(CST + 64 + c4), mv = *(const LAS f32x4*)(CST + 128 + c4);
#pragma unroll
            for (int i = 0; i < 4; ++i) { rr[i] = cr_[i] + (pr_[i] - cr_[i]) * mr[i]; kx[i] = ck_[i] + (pk_[i] - ck_[i]) * mk[i]; vx[i] = cv_[i] + (pv_[i] - cv_[i]) * mv[i]; }
            LAS unsigned char* dst = (j < 4) ? lds + O_XW + tok * RS1 + j * 32 : (j < 8) ? lds + O_XA + tok * RS1 + (j - 4) * 32 : lds + O_XG + tok * RS2 + (j - 8) * 32;
            *(LAS u32x4*)dst = cx0; *(LAS u32x4*)(dst + 16) = cx1;
        }
        if (c > 0) *(u32x2*)(Ob + (size_t)((c - 1) * RW_T + tok) * RWW) = wout;
        __syncthreads();
        if (wv < 6) {
            const int prod = wv >> 1, nt = wv & 1;
            const int xo = prod == 0 ? O_XW : (prod == 1 ? O_XA : O_XG), wo = prod == 0 ? O_W2 : (prod == 1 ? O_A2 : O_G2), rs = prod == 2 ? RS2 : RS1, nk = prod == 2 ? 8 : 4;
            const int po = prod == 0 ? O_PW : (prod == 1 ? O_PA : O_GG);
            f32x16 acc = zero16();
            for (int kk = 0; kk < nk; ++kk) {
                const bf16x8 af = *(const LAS bf16x8*)(lds + xo + ln * rs + (16 * kk + 8 * lhi) * 2);
                const bf16x8 bf = *(const LAS bf16x8*)(lds + wo + (32 * nt + ln) * rs + (16 * kk + 8 * lhi) * 2);
                acc = __builtin_amdgcn_mfma_f32_32x32x16_bf16(af, bf, acc, 0, 0, 0);
            }
            LAS float* pd = (LAS float*)(lds + po) + 32 * nt + ln;
#pragma unroll
            for (int r = 0; r < 16; ++r) pd[((r & 3) + 8 * (r >> 2) + 4 * lhi) * 64] = acc[r];
        }
        __syncthreads();
        float bonus; f32x4 av, nkk, bb, kef;
        {
            const f32x4 wp = *(const LAS f32x4*)(lds + O_PW + (tok * 64 + c4) * 4), ap = *(const LAS f32x4*)(lds + O_PA + (tok * 64 + c4) * 4);
            const f32x4 w0 = *(const LAS f32x4*)(CST + 448 + c4), a0 = *(const LAS f32x4*)(CST + 512 + c4), k_k = *(const LAS f32x4*)(CST + 576 + c4), k_a = *(const LAS f32x4*)(CST + 640 + c4), r_k = *(const LAS f32x4*)(CST + 704 + c4);
            f32x4 dec, kkv; float n2 = 0.f, bs = 0.f;
#pragma unroll
            for (int i = 0; i < 4; ++i) {
                const float xw = -(w0[i] + wp[i]);
                const float sp = fmaxf(xw, 0.f) + flog1p_(__expf(-fabsf(xw)));
                dec[i] = __expf(-__expf(-sp - 0.5f));
                av[i] = sigm(a0[i] + ap[i]);
                kkv[i] = kx[i] * k_k[i]; n2 += kkv[i] * kkv[i];
                kef[i] = kx[i] * (1.f + (av[i] - 1.f) * k_a[i]);
                bs += rr[i] * kef[i] * r_k[i];
            }
            n2 = red16(n2); bonus = red16(bs);
            const float inv = fminf(rsqrtf(n2), 1e12f);
#pragma unroll
            for (int i = 0; i < 4; ++i) { const float kn = kkv[i] * inv; nkk[i] = -kn; bb[i] = kn * av[i]; }
            *(LAS f32x4*)(lds + O_WF + (tok * 64 + c4) * 4) = dec;
        }
        if (c + 1 < SEQ / RW_T) RW_LOAD(c + 1);
        __syncthreads();
        if (wv == 0) {
            float wv_[RW_T];
#pragma unroll
            for (int t = 0; t < RW_T; ++t) wv_[t] = *(const LAS float*)(lds + O_WF + (t * 64 + lane) * 4);
            float g = 1.f;
#pragma unroll
            for (int t = 0; t < RW_T; ++t) { g *= wv_[t]; *(LAS float*)(lds + O_GAM + (t * 64 + lane) * 4) = g; }
        }
        __syncthreads();
        {
            const f32x4 gt = *(const LAS f32x4*)(lds + O_GAM + (tok * 64 + c4) * 4);
            f32x4 gp = {1.f, 1.f, 1.f, 1.f}; if (tok > 0) gp = *(const LAS f32x4*)(lds + O_GAM + ((tok - 1) * 64 + c4) * 4);
            float at[4], rt[4], bt[4], kt[4];
#pragma unroll
            for (int i = 0; i < 4; ++i) { const float ig = __builtin_amdgcn_rcpf(gt[i]); at[i] = gp[i] * nkk[i]; rt[i] = gt[i] * rr[i]; bt[i] = bb[i] * ig; kt[i] = kef[i] * ig; }
            u32x2 w;
            w.x = pkbf(at[0], at[1]); w.y = pkbf(at[2], at[3]); *(LAS u32x2*)(lds + O_AT + tok * RS1 + c4 * 2) = w;
            w.x = pkbf(rt[0], rt[1]); w.y = pkbf(rt[2], rt[3]); *(LAS u32x2*)(lds + O_RT + tok * RS1 + c4 * 2) = w;
            w.x = pkbf(bt[0], bt[1]); w.y = pkbf(bt[2], bt[3]); *(LAS u32x2*)(lds + O_BT + tok * RS1 + c4 * 2) = w;
            w.x = pkbf(kt[0], kt[1]); w.y = pkbf(kt[2], kt[3]); *(LAS u32x2*)(lds + O_KT + tok * RS1 + c4 * 2) = w;
#pragma unroll
            for (int i = 0; i < 4; ++i) {
                *(LAS bf16_t*)(lds + O_BTT + (c4 + i) * RS3 + tok * 2) = (bf16_t)(pkbf(bt[i], 0.f) & 0xffffu);
                *(LAS bf16_t*)(lds + O_KTT + (c4 + i) * RS3 + tok * 2) = (bf16_t)(pkbf(kt[i], 0.f) & 0xffffu);
                *(LAS bf16_t*)(lds + O_VT + (c4 + i) * RS3 + tok * 2) = (bf16_t)(pkbf(vx[i], 0.f) & 0xffffu);
            }
        }
        __syncthreads();
        f32x16 acc = zero16();
        if (wv == 0) {
            const f32x16 l = mm_tile<4>(zero16(), lds + O_AT, RS1, lds + O_BT, RS1, lane);
#pragma unroll
            for (int r = 0; r < 16; ++r) { const int t = (r & 3) + 8 * (r >> 2) + 4 * lhi; *(LAS float*)(lds + O_LABF + (t * 32 + ln) * 4) = (ln < t) ? l[r] : 0.f; }
        } else if (wv == 1) {
            const f32x16 l = mm_tile<4>(zero16(), lds + O_RT, RS1, lds + O_BT, RS1, lane);
#pragma unroll
            for (int r = 0; r < 16; ++r) { const int t = (r & 3) + 8 * (r >> 2) + 4 * lhi; *(LAS bf16_t*)(lds + O_LRB + t * RS3 + ln * 2) = (bf16_t)(pkbf((ln <= t) ? l[r] : 0.f, 0.f) & 0xffffu); }
        } else if (wv >= 4) {
            const int incl = (wv >= 6);
            const f32x16 l = mm_tile<4>(zero16(), lds + (wv < 6 ? O_AT : O_RT), RS1, lds + O_KT, RS1, lane);
            LAS unsigned char* ld = lds + (wv < 6 ? O_LAK : O_LRK) + ln * 2;
#pragma unroll
            for (int r = 0; r < 16; ++r) { const int t = (r & 3) + 8 * (r >> 2) + 4 * lhi; *(LAS bf16_t*)(ld + t * RS3) = (bf16_t)(pkbf((ln < t + incl) ? l[r] : 0.f, 0.f) & 0xffffu); }
            acc = mm_tile<4>(acc, lds + (wv < 6 ? O_AT : O_RT), RS1, lds + O_SIMG + 32 * (wv & 1) * RS1, RS1, lane);
        }
        for (int irep = 0; irep < (PROBE_PHASE == 30 ? 2 : 1); ++irep)
        if (wv == 0) {
            float x[16]; const int blk = (lane >> 4) & 1, lc = lane & 15;
            const LAS unsigned char* lrow = lds + O_LABF + ((16 * blk) * 32 + 16 * blk + lc) * 4;
            x[0] = (lc == 0) ? 1.f : 0.f;
#define RW_FD(acc_, lv_, xv_, n_) asm("v_fmac_f32_dpp %0, %1, %2 row_newbcast:" #n_ " row_mask:0xf bank_mask:0xf" : "+v"(acc_) : "v"(lv_), "v"(xv_))
#define RW_T1(acc_, la_, jq) do { switch (jq) { \
        case 0: RW_FD(acc_, la_, x[jq], 0); break; case 1: RW_FD(acc_, la_, x[jq], 1); break; case 2: RW_FD(acc_, la_, x[jq], 2); break; case 3: RW_FD(acc_, la_, x[jq], 3); break; \
        case 4: RW_FD(acc_, la_, x[jq], 4); break; case 5: RW_FD(acc_, la_, x[jq], 5); break; case 6: RW_FD(acc_, la_, x[jq], 6); break; case 7: RW_FD(acc_, la_, x[jq], 7); break; \
        case 8: RW_FD(acc_, la_, x[jq], 8); break; case 9: RW_FD(acc_, la_, x[jq], 9); break; case 10: RW_FD(acc_, la_, x[jq], 10); break; case 11: RW_FD(acc_, la_, x[jq], 11); break; \
        case 12: RW_FD(acc_, la_, x[jq], 12); break; case 13: RW_FD(acc_, la_, x[jq], 13); break; case 14: RW_FD(acc_, la_, x[jq], 14); break; default: RW_FD(acc_, la_, x[jq], 15); break; } } while (0)
#define RW_T2(t, jq) do { if ((jq) < (t)) { RW_T1(sa, la0, jq); RW_T1(sb, la1, jq); } } while (0)
#pragma unroll
            for (int t = 1; t < 16; t += 2) {
                const int t1 = (t + 1 < 16) ? t + 1 : t;
                float sa = (t == lc) ? 1.f : 0.f, sb = (t1 == lc) ? 1.f : 0.f;
                const float la0 = *(const LAS float*)(lrow + t * 128), la1 = *(const LAS float*)(lrow + t1 * 128);
                RW_T2(t, 0); RW_T2(t, 1); RW_T2(t, 2); RW_T2(t, 3); RW_T2(t, 4); RW_T2(t, 5); RW_T2(t, 6); RW_T2(t, 7); RW_T2(t, 8); RW_T2(t, 9); RW_T2(t, 10); RW_T2(t, 11); RW_T2(t, 12); RW_T2(t, 13); RW_T2(t, 14);
                x[t] = sa;
                if (t + 1 < 16) { RW_T1(sb, la1, t); x[t + 1] = sb; }
            }
#undef RW_T2
#undef RW_T1
#undef RW_FD
            if (lhi == 0) {
#pragma unroll
                for (int t = 0; t < 16; ++t) { *(LAS bf16_t*)(lds + O_INV + (16 * blk + t) * RS3 + (16 * blk + lc) * 2) = (bf16_t)(pkbf(x[t], 0.f) & 0xffffu);
                    if (blk) *(LAS bf16_t*)(lds + O_INV + t * RS3 + (16 + lc) * 2) = (bf16_t)0; }
            }
            bf16x8 fa, fb; const bool lo16 = (ln < 16);
            {
                const f32x4 c0 = *(const LAS f32x4*)(lds + O_LABF + ((16 + (ln & 15)) * 32 + 8 * lhi) * 4), c1 = *(const LAS f32x4*)(lds + O_LABF + ((16 + (ln & 15)) * 32 + 8 * lhi + 4) * 4);
                u32x4 wa = {pkbf(c0[0], c0[1]), pkbf(c0[2], c0[3]), pkbf(c1[0], c1[1]), pkbf(c1[2], c1[3])}; if (!lo16) wa = (u32x4){0u, 0u, 0u, 0u};
                fa = __builtin_bit_cast(bf16x8, wa);
                float xs[8]; int hm = -lhi; asm volatile("" : "+v"(hm));
#pragma unroll
                for (int e = 0; e < 8; ++e) xs[e] = __int_as_float((__float_as_int(x[8 + e]) & hm) | (__float_as_int(x[e]) & ~hm));
                u32x4 wb = {pkbf(xs[0], xs[1]), pkbf(xs[2], xs[3]), pkbf(xs[4], xs[5]), pkbf(xs[6], xs[7])}; if (!lo16) wb = (u32x4){0u, 0u, 0u, 0u};
                fb = __builtin_bit_cast(bf16x8, wb);
            }
            f32x16 pm_ = __builtin_amdgcn_mfma_f32_32x32x16_bf16(fa, fb, zero16(), 0, 0, 0);
            {
                u32x4 wb = {pkbf(pm_[0], pm_[1]), pkbf(pm_[2], pm_[3]), pkbf(pm_[4], pm_[5]), pkbf(pm_[6], pm_[7])};
                fb = __builtin_bit_cast(bf16x8, wb);
                const LAS unsigned char* dr = lds + O_INV + (16 + (ln & 15)) * RS3 + (16 + 4 * lhi) * 2;
                const u32x2 d0 = *(const LAS u32x2*)dr, d1 = *(const LAS u32x2*)(dr + 16);
                u32x4 wa = {d0.x, d0.y, d1.x, d1.y}; if (!lo16) wa = (u32x4){0u, 0u, 0u, 0u};
                fa = __builtin_bit_cast(bf16x8, wa);
            }
            pm_ = __builtin_amdgcn_mfma_f32_32x32x16_bf16(fa, fb, zero16(), 0, 0, 0);
            if (lo16) {
#pragma unroll
                for (int r = 0; r < 8; ++r) *(LAS bf16_t*)(lds + O_INV + (16 + (r & 3) + 8 * (r >> 2) + 4 * lhi) * RS3 + ln * 2) = (bf16_t)(pkbf(pm_[r], 0.f) & 0xffffu);
            }
        } else if (wv >= 4 && irep == 0) {
            acc = mm_tile<2>(acc, lds + (wv < 6 ? O_LAK : O_LRK), RS3, lds + O_VT + 32 * (wv & 1) * RS3, RS3, lane);
            if (wv < 6) store_T_img(acc, lds + O_WT, 32 * (wv & 1) + ln, lhi);
        }
        __syncthreads();
        if (wv < 4 || wv >= 6) {
            f32x16 u = zero16();
            u = mm_tile<2>(u, lds + O_INV, RS3, lds + O_WT + 32 * (wv & 1) * RS3, RS3, lane);
            store_T_img(u, lds + O_UT, 32 * (wv & 1) + ln, lhi);
        }
        if (wv >= 6) {
            acc = mm_tile<2>(acc, lds + O_LRB, RS3, lds + O_UT + 32 * (wv & 1) * RS3, RS3, lane);
            LAS float* yd = (LAS float*)(lds + O_Y) + 32 * (wv & 1) + ln;
#pragma unroll
            for (int r = 0; r < 16; ++r) yd[((r & 3) + 8 * (r >> 2) + 4 * lhi) * 64] = acc[r];
        } else if (wv < 4) {
            const int kt = wv >> 1, vt = wv & 1;
            St = mm_tile<2>(St, lds + O_BTT + 32 * kt * RS3, RS3, lds + O_UT + 32 * vt * RS3, RS3, lane);
            St = mm_tile<2>(St, lds + O_KTT + 32 * kt * RS3, RS3, lds + O_VT + 32 * vt * RS3, RS3, lane);
#pragma unroll
            for (int i = 0; i < 4; ++i) {
                const f32x4 g4 = *(const LAS f32x4*)(lds + O_GAM + ((RW_T - 1) * 64 + 32 * kt + 8 * i + 4 * lhi) * 4);
#pragma unroll
                for (int e = 0; e < 4; ++e) St[4 * i + e] *= g4[e];
                u32x2 w; w.x = pkbf(St[4 * i], St[4 * i + 1]); w.y = pkbf(St[4 * i + 2], St[4 * i + 3]);
                *(LAS u32x2*)(lds + O_SIMG + (32 * vt + ln) * RS1 + (32 * kt + 8 * i + 4 * lhi) * 2) = w;
            }
        }
        __syncthreads();
        {
            const f32x4 y = *(const LAS f32x4*)(lds + O_Y + (tok * 64 + c4) * 4), g = *(const LAS f32x4*)(lds + O_GG + (tok * 64 + c4) * 4);
            const f32x4 lw = *(const LAS f32x4*)(CST + 768 + c4), lb = *(const LAS f32x4*)(CST + 832 + c4);
            const float mu = red16((y[0] + y[1]) + (y[2] + y[3])) * (1.f / 64.f);
            const f32x4 d = y - mu;
            const float var = red16((d[0] * d[0] + d[1] * d[1]) + (d[2] * d[2] + d[3] * d[3])) * (1.f / 64.f);
            const float rs = rsqrtf(var + 64e-5f);
            float o[4];
#pragma unroll
            for (int i = 0; i < 4; ++i) o[i] = ((d[i] * rs) * lw[i] + lb[i] + bonus * vx[i]) * g[i];
            wout.x = pkbf(o[0], o[1]); wout.y = pkbf(o[2], o[3]);
        }
    }
    *(u32x2*)(Ob + (size_t)(SEQ - RW_T + tok) * RWW) = wout;
#undef RW_LOAD
    __syncthreads();
}

#define XB_TMO      128
#define XB_XCNT(j)  (256  + 64 * (j))
#define XB_XSUB(j)  (1280 + 64 * (j))
#define XB_XGEN(j)  (2304 + 64 * (j))
#define XB_TOP      3328
#define XB_TOPGEN   3392
#define XCD_BAR_WORDS 3456
#define XB_SPIN_CAP (1u << 18)

__device__ __forceinline__ unsigned xb_ld(unsigned* p)              { return __hip_atomic_load(p, __ATOMIC_RELAXED, __HIP_MEMORY_SCOPE_AGENT); }
__device__ __forceinline__ unsigned xb_add(unsigned* p, unsigned v) { return __hip_atomic_fetch_add(p, v, __ATOMIC_RELAXED, __HIP_MEMORY_SCOPE_AGENT); }
__device__ __forceinline__ unsigned xb_xcc_id() { return (unsigned)__builtin_amdgcn_s_getreg((3 << 11) | 20) & 0xFu; }
#define XB_SPIN(cond, bar) do { unsigned _sp = 0; while (cond) { __builtin_amdgcn_s_sleep(1); \
    if ((++_sp & 255u) == 0u) { if (xb_ld(&(bar)[XB_TMO])) break; if (_sp > XB_SPIN_CAP) { atomicAdd(&(bar)[XB_TMO], 1u); break; } } } } while (0)

struct XcdBarrier {
    unsigned* bar; unsigned x;
    volatile LAS unsigned* st;
};

__device__ __forceinline__ XcdBarrier xcd_barrier_post(unsigned* bar, volatile LAS unsigned* st) {
    XcdBarrier b; b.bar = bar; b.x = xb_xcc_id(); b.st = st;
    if (threadIdx.x == 0) (void)xb_add(&bar[XB_XCNT(b.x)], 1u);
    return b;
}
__device__ __forceinline__ void xcd_barrier_complete(unsigned* bar, unsigned x, unsigned& nloc, unsigned& nx) {
    const unsigned G = gridDim.x * gridDim.y * gridDim.z;
    unsigned sum, cnt, mine, sp = 0u;
    for (;;) {
        sum = 0u; cnt = 0u; mine = 0u;
#pragma unroll
        for (unsigned j = 0; j < 16; ++j) { const unsigned c = xb_ld(&bar[XB_XCNT(j)]); sum += c; cnt += (c > 0u) ? 1u : 0u; mine = (j == x) ? c : mine; }
        if (sum == G) break;
        __builtin_amdgcn_s_sleep(1);
        if ((++sp & 255u) == 0u) { if (xb_ld(&bar[XB_TMO])) break; if (sp > XB_SPIN_CAP) { atomicAdd(&bar[XB_TMO], 1u); break; } }
    }
    nloc = mine > 0u ? mine : 1u; nx = cnt > 0u ? cnt : 1u;
}

__device__ __forceinline__ void xcd_barrier(const XcdBarrier& b) {
    asm volatile("s_waitcnt vmcnt(0)" ::: "memory");
    __syncthreads();
    if (threadIdx.x == 0) {
        unsigned* bar = b.bar;
        __builtin_amdgcn_s_waitcnt(0);
        unsigned nloc = b.st[0], nx = b.st[1];
        if (nloc == 0u) { xcd_barrier_complete(bar, b.x, nloc, nx); b.st[0] = nloc; b.st[1] = nx; }
        const unsigned old = xb_add(&bar[XB_XSUB(b.x)], 1u);
        const unsigned gen = old / nloc;
        if (old + 1u == (gen + 1u) * nloc) {
            __builtin_amdgcn_fence(__ATOMIC_RELEASE, "agent");
            asm volatile("s_waitcnt vmcnt(0)" ::: "memory");
            const unsigned og = xb_add(&bar[XB_TOP], 1u);
            const unsigned tg = og / nx;
            if (og + 1u == (tg + 1u) * nx) xb_add(&bar[XB_TOPGEN], 1u);
            else XB_SPIN(xb_ld(&bar[XB_TOPGEN]) == tg, bar);
            __builtin_amdgcn_fence(__ATOMIC_ACQUIRE, "agent");
            xb_add(&bar[XB_XGEN(b.x)], 1u);
            asm volatile("s_waitcnt vmcnt(0)" ::: "memory");
        } else {
            XB_SPIN(xb_ld(&bar[XB_XGEN(b.x)]) == gen, bar);
            __builtin_amdgcn_fence(__ATOMIC_ACQUIRE, "agent");
            asm volatile("s_waitcnt vmcnt(0)" ::: "memory");
        }
    }
    __syncthreads();
}

struct Args { const float* in[25]; float* out; unsigned char* ws; int ph_lo, ph_hi; };
enum { I_X = 0, I_P, I_ANG, I_WIN, I_MU, I_W0, I_W2, I_A0, I_A2, I_G2, I_KK, I_KA, I_RK, I_LNW, I_LNB, I_WSB, I_WRW, I_WOUT, I_MNG, I_FF1, I_FF2, I_PNG, I_WPG, I_WPP, I_FNG };

__global__ void __attribute__((target("no-packed-fp32-ops"))) __launch_bounds__(512, 2) fwd_mega(Args a) {
    extern __shared__ __attribute__((aligned(16))) unsigned char lds_raw[];
    LAS unsigned char* lds = (LAS unsigned char*)lds_raw;
    cg::grid_group grid = cg::this_grid();
    const int tid = threadIdx.x, lane = tid & 63, wave = __builtin_amdgcn_readfirstlane(tid >> 6);
    const int G = gridDim.x, gw = blockIdx.x * 8 + wave, NGW = G * 8;
    unsigned char* ws = a.ws;
    bf16_t *WinT = (bf16_t*)(ws + WS_WIN), *WsbT = (bf16_t*)(ws + WS_WSB), *WrwT = (bf16_t*)(ws + WS_WRW), *WoutT = (bf16_t*)(ws + WS_WOUT), *W1T = (bf16_t*)(ws + WS_W1), *W2T = (bf16_t*)(ws + WS_W2),
           *WgT = (bf16_t*)(ws + WS_WG), *WpT = (bf16_t*)(ws + WS_WP), *Lw2T = (bf16_t*)(ws + WS_LW2), *La2T = (bf16_t*)(ws + WS_LA2), *Lg2T = (bf16_t*)(ws + WS_LG2);
    bf16_t *PB = (bf16_t*)(ws + WS_PB), *H = (bf16_t*)(ws + WS_H), *Qb = (bf16_t*)(ws + WS_Q), *Kb = (bf16_t*)(ws + WS_K), *Vt = (bf16_t*)(ws + WS_VT), *U = (bf16_t*)(ws + WS_U), *GT = (bf16_t*)(ws + WS_G),
           *Osb = (bf16_t*)(ws + WS_OSB), *Orw = (bf16_t*)(ws + WS_ORW), *Fb = (bf16_t*)(ws + WS_F), *TMP = (bf16_t*)(ws + WS_TMP);
    bf16_t* MG = H; bf16_t* XB1 = Osb; bf16_t* XACT = H;
    unsigned* CNT = (unsigned*)(ws + 832 * 1024);
    float *SS1 = (float*)ws, *SS2 = SS1 + MT, *SS3 = SS2 + MT;
    float* X = a.out;
#define IN(k) (a.ph_lo <= (k) && (k) < a.ph_hi)
#define REP(k) for (int rep_ = 0; rep_ < ((k) == PROBE_PHASE ? 2 : 1); ++rep_)
#define SEAM(k) do { if (a.ph_lo <= (k) && (k) + 1 < a.ph_hi) xcd_barrier(xbar); } while (0)
    volatile LAS unsigned* xst = (volatile LAS unsigned*)(lds + LDS_BYTES - 64);
    if (tid == 0) { xst[0] = 0u; xst[1] = 0u; }
    __syncthreads();
    const XcdBarrier xbar = xcd_barrier_post((unsigned*)(ws + WS_XBAR), xst);
    if (a.ph_hi < 0) grid.sync();

    if (IN(0)) REP(0) {
        LAS float* scr = (LAS float*)(lds + wave * 16384);
        constexpr int I0 = 16 * 168, I1 = 8 * 32, I2 = 8 * 32, I3 = 16 * 32, I4 = 16 * 128, I5 = 64 * 32, I6 = 16 * 32, I7 = 4 * 32, I8 = 16, I9 = 16, I10 = 32;
        constexpr int NIT = I0 + I1 + I2 + I3 + I4 + I5 + I6 + I7 + I8 + I9 + I10;
        for (int it = gw; it < NIT; it += NGW) {
            int r = it;
            if (r < I0) { const int kb = r / 168, nb = r % 168; transpose_item(a.in[I_WIN], DM, INC, WinT, 64 * kb, 32 * nb, win_dst(32 * nb), scr, lane); continue; } r -= I0;
            if (r < I1) { const int kb = r / 32, nb = r % 32; transpose_item(a.in[I_WSB], SBW, DM, WsbT, 64 * kb, 32 * nb, 32 * nb, scr, lane); continue; } r -= I1;
            if (r < I2) { const int kb = r / 32, nb = r % 32; transpose_item(a.in[I_WRW], RWW, DM, WrwT, 64 * kb, 32 * nb, 32 * nb, scr, lane); continue; } r -= I2;
            if (r < I3) { const int kb = r / 32, nb = r % 32; transpose_item(a.in[I_WOUT], DM, DM, WoutT, 64 * kb, 32 * nb, 32 * nb, scr, lane); continue; } r -= I3;
            if (r < I4) { const int kb = r / 128, nb = r % 128; transpose_item(a.in[I_FF1], DM, FF, W1T, 64 * kb, 32 * nb, 32 * nb, scr, lane, a.in[I_MNG]); continue; } r -= I4;
            if (r < I5) { const int kb = r / 32, nb = r % 32; transpose_item(a.in[I_FF2], FF, DM, W2T, 64 * kb, 32 * nb, 32 * nb, scr, lane); continue; } r -= I5;
            if (r < I6) { const int kb = r / 32, nb = r % 32; transpose_item(a.in[I_WPG], DM, DM, WgT, 64 * kb, 32 * nb, 32 * nb, scr, lane, a.in[I_PNG]); continue; } r -= I6;
            if (r < I7) { const int kb = r / 32, nb = r % 32; transpose_item(a.in[I_WPP], PLE, DM, WpT, 64 * kb, 32 * nb, 32 * nb, scr, lane); continue; } r -= I7;
            if (r < I8) { transpose_item(a.in[I_W2], 64, RWW, Lw2T, 0, 32 * r, 32 * r, scr, lane); continue; } r -= I8;
            if (r < I9) { transpose_item(a.in[I_A2], 64, RWW, La2T, 0, 32 * r, 32 * r, scr, lane); continue; } r -= I9;
            { const int kb = r / 16, nb = r % 16; transpose_item(a.in[I_G2], 128, RWW, Lg2T, 64 * kb, 32 * nb, 32 * nb, scr, lane); }
        }
        for (int m = gw; m < MT; m += NGW) rms_row_bf16(a.in[I_X] + (size_t)m * DM, a.in[I_ANG], H + (size_t)m * DM, lane);
        for (int i = blockIdx.x * 512 + tid; i < 3 * MT; i += G * 512) SS1[i] = 0.f;
        for (int i = blockIdx.x * 512 + tid; i < 64 * 256; i += G * 512) CNT[i] = 0u;
        {
            const f32x4* src = (const f32x4*)a.in[I_P]; u32x4* dst = (u32x4*)PB; const size_t n8 = (size_t)MT * PLE / 8;
            for (size_t i = (size_t)blockIdx.x * 512 + tid; i < n8; i += (size_t)G * 512) { const f32x4 v0 = src[2 * i], v1 = src[2 * i + 1]; dst[i] = pack8(v0, v1); }
        }
    }
    SEAM(0);
    if (IN(1)) REP(1) {
        run_gemm(lds, H, WinT, MT, NMAIN, DM, FInproj{Qb, Kb, U, GT});
        run_gemm(lds, WinT + (size_t)NMAIN * DM, H, SBW, MT, DM, FStore{Vt, MT});
    }
    SEAM(1);
    if (IN(2)) {
        const float* mu = a.in[I_MU] + 1536;
        for (int it = blockIdx.x * 512 + tid; it < MT * 32; it += G * 512) {
            const int m = it >> 5, c8 = (it & 31) * 8; const bf16_t* rp = U + (size_t)m * RWC + 1536 + c8;
            const u32x4 cw = *(const u32x4*)rp; u32x4 pw = {0u, 0u, 0u, 0u}; if ((m & (SEQ - 1)) != 0) pw = *(const u32x4*)(rp - RWC);
            const f32x4 m0 = *(const f32x4*)(mu + c8), m1 = *(const f32x4*)(mu + c8 + 4);
            f32x4 c0, c1, p0, p1; unpack8(cw, c0, c1); unpack8(pw, p0, p1);
            f32x4 x0 = c0 + (p0 - c0) * m0, x1 = c1 + (p1 - c1) * m1;
            if (c8 < 64) {
#pragma unroll
                for (int e = 0; e < 4; ++e) { x0[e] = 1.f - 2.f * __builtin_amdgcn_rcpf(1.f + __expf(2.f * x0[e])); x1[e] = 1.f - 2.f * __builtin_amdgcn_rcpf(1.f + __expf(2.f * x1[e])); }
            } else if (c8 >= 128) { x0 = sigm4(x0); x1 = sigm4(x1); }
            *(u32x4*)(XACT + (size_t)m * 256 + c8) = pack8(x0, x1);
        }
    }
    if (IN(2)) REP(2) {
        for (int u = gw; u < NB * NH * (SEQ / 32); u += NGW) sb_attn_unit(Qb, Kb, Vt, Osb, u >> 6, u & 63, lane);
        if (a.ph_hi - a.ph_lo > 1) xcd_barrier(xbar);
        RwParams P{U, XACT, Lw2T, La2T, Lg2T, a.in[I_MU], a.in[I_W0], a.in[I_A0], a.in[I_KK], a.in[I_KA], a.in[I_RK], a.in[I_LNW], a.in[I_LNB], Orw};
        for (int bh = blockIdx.x; bh < NB * NH; bh += G) rwkv_unit(P, bh, lds);
    }
    SEAM(2);
    if (IN(3)) REP(3) {
        run_gemm<false>(lds, Osb, WsbT, MT, DM, SBW, FMergeA{GT, MG});
        run_gemm<false>(lds, Orw, WrwT, MT, DM, RWW, FMergeB{GT, MG});
    }
    SEAM(3);
    if (IN(4)) REP(4) run_gemm(lds, MG, WoutT, MT, DM, DM, FRes4{a.in[I_X], XB1, SS1});
    SEAM(4);
    if (IN(6)) REP(6) run_gemm(lds, XB1, W1T, MT, FF, DM, FRelu2{Fb, SS1});
    SEAM(6);
    if (IN(7)) run_gemm(lds, Fb, W2T, MT, DM, FF, FRes7{XB1, H, SS2});
    SEAM(7);
    if (IN(9)) {
        run_gemm<false>(lds, PB, WpT, MT, DM, PLE, FStore{TMP, DM});
        {
            pg8::Gemm g{H, WgT, MT, DM, DM}; const pg8::StaticOrder S{MT / 256, DM / 256, (MT / 256) * (DM / 256), (int)gridDim.x, (int)blockIdx.x};
            EpiPleFinal E{TMP, H, X, SS2, SS3, CNT, a.in[I_FNG]};
            pg8::gemm_phase<EpiPleFinal, pg8::StaticOrder, true, true>(lds, g, S, E);
        }
    }
#undef IN
#undef SEAM
}

extern "C" void kernel_launch(void* const* d_in, const int* in_sizes, int n_in, void* d_out, int out_size, void* d_ws, size_t ws_size, hipStream_t stream) {
    static int grid = 0;
    if (grid == 0) {
        if (n_in != 25 || in_sizes[0] != MT * DM || out_size != MT * DM || ws_size < WS_END) { fprintf(stderr, "kernel_launch: unexpected shapes (n_in %d, in0 %d, out %d, ws %zu); nothing launched\n", n_in, n_in > 0 ? in_sizes[0] : -1, out_size, ws_size); grid = -1; return; }
        int dev = 0, cus = 0, per_cu = 0;
        if (hipGetDevice(&dev) != hipSuccess || hipDeviceGetAttribute(&cus, hipDeviceAttributeMultiprocessorCount, dev) != hipSuccess) { grid = -1; return; }
        if (hipFuncSetAttribute((const void*)fwd_mega, hipFuncAttributeMaxDynamicSharedMemorySize, LDS_BYTES) != hipSuccess) { fprintf(stderr, "kernel_launch: hipFuncSetAttribute failed\n"); grid = -1; return; }
        if (hipOccupancyMaxActiveBlocksPerMultiprocessor(&per_cu, (const void*)fwd_mega, 512, LDS_BYTES) != hipSuccess || per_cu < 1) { fprintf(stderr, "kernel_launch: occupancy query says %d blocks per CU\n", per_cu); per_cu = 1; }
        (void)hipGetLastError();
        grid = cus;
    }
    if (grid < 0) return;
    Args a{};
    for (int i = 0; i < 25; ++i) a.in[i] = (const float*)d_in[i];
    a.out = (float*)d_out; a.ws = (unsigned char*)d_ws;
#if MK_ONE_LAUNCH
    if (hipMemsetAsync((char*)d_ws + WS_XBAR, 0, 16384, stream) != hipSuccess) { fprintf(stderr, "kernel_launch: hipMemsetAsync of the barrier words failed\n"); return; }
    a.ph_lo = 0; a.ph_hi = NPH;
    void* params[] = {&a};
    hipError_t e = hipLaunchCooperativeKernel((const void*)fwd_mega, dim3(grid), dim3(512), params, LDS_BYTES, stream);
    if (e != hipSuccess) fprintf(stderr, "kernel_launch: cooperative launch failed: %s (grid %d)\n", hipGetErrorString(e), grid);
#else
    for (int ph = 0; ph < NPH; ++ph) { a.ph_lo = ph; a.ph_hi = ph + 1; hipLaunchKernelGGL(fwd_mega, dim3(grid), dim3(512), LDS_BYTES, stream, a); }
#endif
}
```
